# Optimizing an MI355X kernel written in HIP

```python
import math
import jax, jax.numpy as jnp
from jax import lax
import numpy as np

D_MODEL = 1024
BATCH = 32
SEQ = 2048
DEPTH = 1

HEAD_DIM = 64
DA_HEADS = 8
DA_V_DIM = 2 * HEAD_DIM
NSA_HEADS = 16
NSA_GROUPS = 2
NSA_HPG = NSA_HEADS // NSA_GROUPS
CMP_BLOCK = 32
CMP_STRIDE = 16
CMP_HIDDEN = 256
SLC_BLOCK = 64
SLC_TOPN = 16
WIN = 512
Q_BLOCK = 128
SLC_Q_BLOCK = 64
D_FF = 2816
ROPE_THETA = 10000.0
EPS = 1e-6
NEG_INF = -1e30
FORCE_SCORE = 1e9

DA_QK_W = DA_HEADS * 2 * HEAD_DIM
DA_V_W = DA_HEADS * DA_V_DIM
NSA_Q_W = NSA_HEADS * HEAD_DIM
NSA_KV_W = NSA_GROUPS * HEAD_DIM
NSA_GATE_W = 3 * NSA_HEADS
IN_WIDTHS = (DA_QK_W, DA_QK_W, DA_V_W, NSA_Q_W) + (NSA_KV_W,) * 6 + (NSA_GATE_W, D_MODEL, D_MODEL)
D_IN = sum(IN_WIDTHS)

kernel_name = 'hybrid_diffattn_nsa_macaron'


def rmsnorm(x, g):
    xf = x.astype(jnp.float32)
    y = xf * lax.rsqrt(jnp.mean(xf * xf, axis=-1, keepdims=True) + EPS)
    return (y * g.astype(jnp.float32)).astype(x.dtype)


def swiglu(h, w1, w3, w2):
    return (jax.nn.silu(h @ w1) * (h @ w3)) @ w2


def rope_tables(T, dim):
    pos = jnp.arange(T, dtype=jnp.float32)
    inv = 1.0 / (ROPE_THETA ** (jnp.arange(0, dim, 2, dtype=jnp.float32) / dim))
    ang = pos[:, None] * inv[None, :]
    return jnp.cos(ang), jnp.sin(ang)


def apply_rope(x, cos, sin):
    half = x.shape[-1] // 2
    shape = (1, x.shape[1]) + (1,) * (x.ndim - 3) + (half,)
    c = cos.reshape(shape).astype(x.dtype)
    s = sin.reshape(shape).astype(x.dtype)
    x1, x2 = x[..., :half], x[..., half:]
    return jnp.concatenate([x1 * c - x2 * s, x2 * c + x1 * s], axis=-1)


def _sweep(block_fn, n_blocks):
    out = lax.map(block_fn, jnp.arange(n_blocks))
    out = jnp.moveaxis(out, 0, 1)
    return out.reshape((out.shape[0], n_blocks * out.shape[2]) + out.shape[3:])


def diff_attention(q, k, v, cos, sin, lam_params, head_gain, lam_init):
    B, T = q.shape[0], q.shape[1]
    q = apply_rope(q, cos, sin)
    k = apply_rope(k, cos, sin)
    lp = lam_params.astype(jnp.float32)
    lam = jnp.exp(jnp.sum(lp[0] * lp[1])) - jnp.exp(jnp.sum(lp[2] * lp[3])) + lam_init
    kpos = jnp.arange(T)
    scale = HEAD_DIM ** -0.5

    def block(i):
        qb = lax.dynamic_slice_in_dim(q, i * Q_BLOCK, Q_BLOCK, axis=1)
        qpos = i * Q_BLOCK + jnp.arange(Q_BLOCK)
        s = jnp.einsum('bqhcd,bkhcd->bhcqk', qb, k).astype(jnp.float32) * scale
        s = jnp.where(kpos[None, :] <= qpos[:, None], s, NEG_INF)
        p = jax.nn.softmax(s, axis=-1)
        a = p[:, :, 0] - lam * p[:, :, 1]
        return jnp.einsum('bhqk,bkhe->bqhe', a.astype(v.dtype), v)

    o = _sweep(block, T // Q_BLOCK)
    o = rmsnorm(o, head_gain) * (1.0 - lam_init)
    return o.reshape(B, T, DA_V_W)


def compress(x_raw, pos, w1, w2):
    B, T = x_raw.shape[0], x_raw.shape[1]
    n_cmp = (T - CMP_BLOCK) // CMP_STRIDE + 1
    idx = np.arange(n_cmp)[:, None] * CMP_STRIDE + np.arange(CMP_BLOCK)[None, :]
    blocks = x_raw[:, idx] + pos[:, None, :]
    blocks = jnp.swapaxes(blocks, 2, 3).reshape(B, n_cmp, NSA_GROUPS, CMP_BLOCK * HEAD_DIM)
    return jax.nn.gelu(blocks @ w1) @ w2


def _overlap_matrix(n_cmp, n_slc):
    start = np.arange(n_cmp) * CMP_STRIDE
    sb = np.arange(n_slc) * SLC_BLOCK
    ov = (start[:, None] < sb[None, :] + SLC_BLOCK) & (start[:, None] + CMP_BLOCK > sb[None, :])
    return ov.astype(np.float32)


def nsa(q, k_cmp, v_cmp, k_slc, v_slc, k_win, v_win, gate_logits, cos, sin, cmp_pos, cmp_w1, cmp_w2):
    B, T = q.shape[0], q.shape[1]
    dt = q.dtype
    scale = HEAD_DIM ** -0.5
    t = jnp.arange(T)

    kc = compress(k_cmp, cmp_pos[0], cmp_w1[0], cmp_w2[0])
    vc = compress(v_cmp, cmp_pos[1], cmp_w1[1], cmp_w2[1])
    n_cmp = kc.shape[1]
    s = jnp.einsum('btgjd,bngd->btgjn', q, kc).astype(jnp.float32) * scale
    c_valid = ((jnp.arange(n_cmp) * CMP_STRIDE + CMP_BLOCK - 1)[None, :] <= t[:, None])[None, :, None, None, :]
    p_cmp = jnp.where(c_valid, jax.nn.softmax(jnp.where(c_valid, s, NEG_INF), axis=-1), 0.0)
    o_cmp = jnp.einsum('btgjn,bngd->btgjd', p_cmp.astype(dt), vc)

    n_slc = T // SLC_BLOCK
    overlap = jnp.asarray(_overlap_matrix(n_cmp, n_slc))
    imp = jnp.einsum('btgjn,ns->btgs', p_cmp, overlap)
    blk_t = t // SLC_BLOCK
    sblk = jnp.arange(n_slc)
    causal = sblk[None, :] <= blk_t[:, None]
    forced = (sblk[None, :] == 0) | (sblk[None, :] == blk_t[:, None]) | (sblk[None, :] == blk_t[:, None] - 1)
    score = jnp.where(forced[None, :, None, :], FORCE_SCORE,
                      jnp.where(causal[None, :, None, :], imp, -1.0))
    _, sel = lax.top_k(score, min(SLC_TOPN, n_slc))
    sel_valid = sel <= blk_t[None, :, None, None]

    qr = apply_rope(q, cos, sin)
    ks = apply_rope(k_slc, cos, sin)
    kw = apply_rope(k_win, cos, sin)

    ks_blk = ks.reshape(B, n_slc, SLC_BLOCK, NSA_GROUPS, HEAD_DIM).transpose(0, 3, 1, 2, 4)
    vs_blk = v_slc.reshape(B, n_slc, SLC_BLOCK, NSA_GROUPS, HEAD_DIM).transpose(0, 3, 1, 2, 4)
    bidx = jnp.arange(B)[:, None, None, None]
    gidx = jnp.arange(NSA_GROUPS)[None, None, :, None]

    def slc_block(i):
        qb = lax.dynamic_slice_in_dim(qr, i * SLC_Q_BLOCK, SLC_Q_BLOCK, axis=1)
        selb = lax.dynamic_slice_in_dim(sel, i * SLC_Q_BLOCK, SLC_Q_BLOCK, axis=1)
        validb = lax.dynamic_slice_in_dim(sel_valid, i * SLC_Q_BLOCK, SLC_Q_BLOCK, axis=1)
        qpos = i * SLC_Q_BLOCK + jnp.arange(SLC_Q_BLOCK)
        kg = ks_blk[bidx, gidx, selb]
        vg = vs_blk[bidx, gidx, selb]
        kpos = selb[..., None] * SLC_BLOCK + jnp.arange(SLC_BLOCK)
        mask = validb[..., None] & (kpos <= qpos[None, :, None, None, None])
        s = jnp.einsum('bqgjd,bqgnld->bqgjnl', qb, kg).astype(jnp.float32) * scale
        s = jnp.where(mask[:, :, :, None], s, NEG_INF)
        sh = s.shape
        p = jax.nn.softmax(s.reshape(sh[:4] + (-1,)), axis=-1).reshape(sh)
        return jnp.einsum('bqgjnl,bqgnld->bqgjd', p.astype(dt), vg)

    o_slc = _sweep(slc_block, T // SLC_Q_BLOCK)

    kw_pad = jnp.pad(kw, ((0, 0), (WIN, 0), (0, 0), (0, 0)))
    vw_pad = jnp.pad(v_win, ((0, 0), (WIN, 0), (0, 0), (0, 0)))

    def win_block(i):
        qb = lax.dynamic_slice_in_dim(qr, i * Q_BLOCK, Q_BLOCK, axis=1)
        qpos = i * Q_BLOCK + jnp.arange(Q_BLOCK)
        kb = lax.dynamic_slice_in_dim(kw_pad, i * Q_BLOCK, WIN + Q_BLOCK, axis=1)
        vb = lax.dynamic_slice_in_dim(vw_pad, i * Q_BLOCK, WIN + Q_BLOCK, axis=1)
        kpos = i * Q_BLOCK - WIN + jnp.arange(WIN + Q_BLOCK)
        mask = (kpos[None, :] >= 0) & (kpos[None, :] <= qpos[:, None]) & (kpos[None, :] > qpos[:, None] - WIN)
        s = jnp.einsum('bqgjd,bkgd->bqgjk', qb, kb).astype(jnp.float32) * scale
        s = jnp.where(mask[None, :, None, None, :], s, NEG_INF)
        p = jax.nn.softmax(s, axis=-1)
        return jnp.einsum('bqgjk,bkgd->bqgjd', p.astype(dt), vb)

    o_win = _sweep(win_block, T // Q_BLOCK)

    g = jax.nn.sigmoid(gate_logits.astype(jnp.float32)).astype(dt).reshape(B, T, NSA_GROUPS, NSA_HPG, 3)
    o = g[..., 0:1] * o_cmp + g[..., 1:2] * o_slc + g[..., 2:3] * o_win
    return o.reshape(B, T, NSA_Q_W)


def token_mix(h, w_in, da_lambda, da_head_norm, cmp_pos, cmp_w1, cmp_w2, w_proj_da, w_proj_nsa, w_out, lam_init):
    B, T = h.shape[0], h.shape[1]
    proj = h @ w_in
    offs = []
    acc = 0
    for w in IN_WIDTHS[:-1]:
        acc += w
        offs.append(acc)
    (q_da, k_da, v_da, q_ns, kc_raw, vc_raw, ks_raw, vs_raw, kw_raw, vw_raw,
     g_ns, g_a, g_b) = jnp.split(proj, offs, axis=-1)
    cos, sin = rope_tables(T, HEAD_DIM)
    y_da = diff_attention(q_da.reshape(B, T, DA_HEADS, 2, HEAD_DIM),
                          k_da.reshape(B, T, DA_HEADS, 2, HEAD_DIM),
                          v_da.reshape(B, T, DA_HEADS, DA_V_DIM),
                          cos, sin, da_lambda, da_head_norm, lam_init)
    kv = lambda a: a.reshape(B, T, NSA_GROUPS, HEAD_DIM)
    y_ns = nsa(q_ns.reshape(B, T, NSA_GROUPS, NSA_HPG, HEAD_DIM),
               kv(kc_raw), kv(vc_raw), kv(ks_raw), kv(vs_raw), kv(kw_raw), kv(vw_raw),
               g_ns, cos, sin, cmp_pos, cmp_w1, cmp_w2)
    merged = jax.nn.sigmoid(g_a) * (y_da @ w_proj_da) + jax.nn.sigmoid(g_b) * (y_ns @ w_proj_nsa)
    return merged @ w_out


def setup_inputs(seed: int = 0) -> dict:
    key = jax.random.key(seed)
    ks = jax.random.split(key, 24)
    f32 = jnp.float32

    def w(k, shape, fan_in):
        return jax.random.normal(k, shape, f32) * fan_in ** -0.5

    def gain(k, shape):
        return 1.0 + 0.05 * jax.random.normal(k, shape, f32)

    return {
        'x': jax.random.normal(ks[0], (BATCH, SEQ, D_MODEL), f32),
        'ffn1_norm': gain(ks[1], (DEPTH, D_MODEL)),
        'ffn1_w1': w(ks[2], (DEPTH, D_MODEL, D_FF), D_MODEL),
        'ffn1_w3': w(ks[3], (DEPTH, D_MODEL, D_FF), D_MODEL),
        'ffn1_w2': w(ks[4], (DEPTH, D_FF, D_MODEL), D_FF),
        'mix_norm': gain(ks[5], (DEPTH, D_MODEL)),
        'w_in': w(ks[6], (DEPTH, D_MODEL, D_IN), D_MODEL),
        'da_lambda': 0.1 * jax.random.normal(ks[7], (DEPTH, 4, HEAD_DIM), f32),
        'da_head_norm': gain(ks[8], (DEPTH, DA_HEADS, DA_V_DIM)),
        'cmp_pos': 0.1 * jax.random.normal(ks[9], (DEPTH, 2, CMP_BLOCK, HEAD_DIM), f32),
        'cmp_w1': w(ks[10], (DEPTH, 2, CMP_BLOCK * HEAD_DIM, CMP_HIDDEN), CMP_BLOCK * HEAD_DIM),
        'cmp_w2': w(ks[11], (DEPTH, 2, CMP_HIDDEN, HEAD_DIM), CMP_HIDDEN),
        'w_proj_da': w(ks[12], (DEPTH, DA_V_W, D_MODEL), DA_V_W),
        'w_proj_nsa': w(ks[13], (DEPTH, NSA_Q_W, D_MODEL), NSA_Q_W),
        'w_out': w(ks[14], (DEPTH, D_MODEL, D_MODEL), D_MODEL),
        'ffn2_norm': gain(ks[15], (DEPTH, D_MODEL)),
        'ffn2_w1': w(ks[16], (DEPTH, D_MODEL, D_FF), D_MODEL),
        'ffn2_w3': w(ks[17], (DEPTH, D_MODEL, D_FF), D_MODEL),
        'ffn2_w2': w(ks[18], (DEPTH, D_FF, D_MODEL), D_FF),
        'final_norm': gain(ks[19], (D_MODEL,)),
    }


def reference(x, ffn1_norm, ffn1_w1, ffn1_w3, ffn1_w2, mix_norm, w_in, da_lambda, da_head_norm,
              cmp_pos, cmp_w1, cmp_w2, w_proj_da, w_proj_nsa, w_out,
              ffn2_norm, ffn2_w1, ffn2_w3, ffn2_w2, final_norm):
    for l in range(DEPTH):
        lam_init = 0.8 - 0.6 * math.exp(-0.3 * l)
        h = rmsnorm(x, ffn1_norm[l])
        x = x + 0.5 * swiglu(h, ffn1_w1[l], ffn1_w3[l], ffn1_w2[l])
        h = rmsnorm(x, mix_norm[l])
        x = x + token_mix(h, w_in[l], da_lambda[l], da_head_norm[l], cmp_pos[l], cmp_w1[l], cmp_w2[l],
                          w_proj_da[l], w_proj_nsa[l], w_out[l], lam_init)
        h = rmsnorm(x, ffn2_norm[l])
        x = x + 0.5 * swiglu(h, ffn2_w1[l], ffn2_w3[l], ffn2_w2[l])
    return rmsnorm(x, final_norm)
```

```cpp
#include <hip/hip_runtime.h>
#include <hip/hip_cooperative_groups.h>
#include <cstdio>
#include <cstdint>
namespace cg = cooperative_groups;
namespace pg8 {
#define PG8_LAS __attribute__((address_space(3)))
typedef unsigned short bf16_t;
typedef short bf16x8 __attribute__((ext_vector_type(8)));
typedef float f32x4 __attribute__((ext_vector_type(4)));
typedef unsigned u32x4 __attribute__((ext_vector_type(4)));
constexpr int BM = 256, BK = 64, HALF = 128, HTB = HALF * BK * 2  , STAGE_BYTES = 8 * HTB, NXCD = 8, WGM = 8;

__host__ __device__ __forceinline__ int lds_byte(int r, int c) { const int st = (r >> 4) * 2 + (c >> 5), rr = r & 15, cc = c & 31, ob = rr * 64 + cc * 2; return st * 1024 + (ob ^ (((ob >> 9) & 1) << 5)); }
__host__ __device__ __forceinline__ void stage_rc(int b, int& R, int& C) { const int st = b / 1024, sb = b % 1024, swz = sb ^ (((sb >> 9) & 1) << 5); R = (st >> 1) * 16 + swz / 64; C = (st & 1) * 32 + (swz % 64) / 2; }
__host__ __device__ __forceinline__ int perm32(int rho) { const int n = rho >> 4, i = rho & 15; return 8 * (i >> 2) + 4 * n + (i & 3); }

struct Unit { int pm, pn; };
struct Gemm { const bf16_t* A; const bf16_t* Bt; int M, N, K; };

struct StaticOrder {
    int nM, nN, nwg, G, c;
    __host__ __device__ void init(int M, int N, int G_, int c_) { nM = M / BM; nN = N / BM; nwg = nM * nN; G = G_; c = c_; }
    __host__ __device__ bool next(int i, Unit& u) const {
        const long L = (long)i * G + c; if (L >= nwg) return false;
        int wgid = (int)L; { const int q = nwg / NXCD, r = nwg % NXCD, xcd = wgid % NXCD, off = wgid / NXCD; wgid = (xcd < r ? xcd * (q + 1) : r * (q + 1) + (xcd - r) * q) + off; }
        const int nig = WGM * nN, gid = wgid / nig, fm = gid * WGM, gsz = (nM - fm) < WGM ? (nM - fm) : WGM;
        u.pm = fm + ((wgid % nig) % gsz); u.pn = (wgid % nig) / gsz; return true;
    }
    __device__ __forceinline__ void a_ready(const Unit&) const {}
    __device__ __forceinline__ void done(const Unit&) const {}
};

__device__ __forceinline__ unsigned cvt_pk_bf16(float lo, float hi) { unsigned r; asm volatile("v_cvt_pk_bf16_f32 %0, %1, %2" : "=v"(r) : "v"(lo), "v"(hi)); return r; }
template <class Epi, class Sched, bool ALIGN_EPI = false, bool SP2 = false>
__device__ __forceinline__ void gemm_phase(PG8_LAS unsigned char* lds, const Gemm g, const Sched& S, const Epi& E) {
    int tid_ = threadIdx.x; asm volatile("" : "+v"(tid_));
    const int tid = tid_, wid = __builtin_amdgcn_readfirstlane(tid >> 6), lane = tid & 63, wr = wid >> 2, wc = wid & 3, fr = lane & 15, fq = lane >> 4;
    const int K = g.K, nt = K / BK;
    unsigned voffA[2], voffB[2];
#pragma unroll
    for (int i = 0; i < 2; ++i) { int R, C; stage_rc(tid * 16 + i * 8192, R, C); const int Rb = Epi::PERM ? ((R & ~31) + perm32(R & 31)) : R;
        voffA[i] = (unsigned)(R * K + C) * 2u; voffB[i] = (unsigned)(Rb * K + C) * 2u; }
    const size_t kstep = (size_t)(BK * 2);
    const size_t hstep = (size_t)HALF * K * 2;
    const size_t tstep = 2 * hstep;
    const unsigned ldsw = (unsigned)wid * 1024u;
    const int aoff = lds_byte(wr * 64 + fr, fq * 8), boff = lds_byte(wc * 32 + fr, fq * 8);
#define PG8_SA(b, h) (((b) * 2 + (h)) * HTB)
#define PG8_SB(b, h) ((4 + (b) * 2 + (h)) * HTB)
#define PG8_STAGE(bufoff, gbase, voff) do { _Pragma("unroll") for (int _i = 0; _i < 2; ++_i) \
        __builtin_amdgcn_global_load_lds((const unsigned*)((const char*)(gbase) + (voff)[_i]), (PG8_LAS unsigned*)(lds + (bufoff) + ldsw + _i * 8192), 16, 0, 0); } while (0)
#define PG8_LDA(dst, b, h) do { _Pragma("unroll") for (int m = 0; m < 4; ++m) _Pragma("unroll") for (int k = 0; k < 2; ++k) dst[m][k] = *(const PG8_LAS bf16x8*)(lds + PG8_SA(b, h) + aoff + m * 2048 + k * 1024); } while (0)
#define PG8_LDB(dst, b, h) do { _Pragma("unroll") for (int n = 0; n < 2; ++n) _Pragma("unroll") for (int k = 0; k < 2; ++k) dst[n][k] = *(const PG8_LAS bf16x8*)(lds + PG8_SB(b, h) + boff + n * 2048 + k * 1024); } while (0)
#define PG8_MMA(ai, bj, At, Bt) do { __builtin_amdgcn_s_setprio(1); _Pragma("unroll") for (int m = 0; m < 4; ++m) _Pragma("unroll") for (int n = 0; n < 2; ++n) _Pragma("unroll") for (int k = 0; k < 2; ++k) \
        acc[ai][bj][m][n] = __builtin_amdgcn_mfma_f32_16x16x32_bf16(Bt[n][k], At[m][k], acc[ai][bj][m][n], 0, 0, 0); __builtin_amdgcn_s_setprio(0); } while (0)
#define PG8_WAIT_V(n) asm volatile("s_waitcnt vmcnt(" #n ")" ::: "memory")
#define PG8_WAIT_L(n) asm volatile("s_waitcnt lgkmcnt(" #n ")" ::: "memory")
#define PG8_BAR __builtin_amdgcn_s_barrier()
#define PG8_SCHED __builtin_amdgcn_sched_barrier(0)
    Unit cur, nxt; int ui = 0;
    if (!S.next(0, cur)) return;
    f32x4 acc[2][2][4][2];
#pragma unroll
    for (int a = 0; a < 2; ++a)
#pragma unroll
        for (int b = 0; b < 2; ++b)
#pragma unroll
            for (int m = 0; m < 4; ++m)
#pragma unroll
                for (int n = 0; n < 2; ++n) acc[a][b][m][n] = (f32x4){0.f, 0.f, 0.f, 0.f};
    bf16x8 At[4][2], B0[2][2], B1[2][2];
    const char* cA = (const char*)g.A + (size_t)cur.pm * tstep; const char* cB = (const char*)g.Bt + (size_t)cur.pn * tstep;
    S.a_ready(cur);
    if constexpr (SP2) {
        PG8_STAGE(PG8_SB(0, 0), cB, voffB); PG8_STAGE(PG8_SB(0, 1), cB + hstep, voffB); PG8_STAGE(PG8_SA(0, 0), cA, voffA); PG8_STAGE(PG8_SA(0, 1), cA + hstep, voffA);
        if (wr == 1) PG8_BAR;
        PG8_WAIT_V(2); PG8_BAR;
        PG8_STAGE(PG8_SB(1, 0), cB + kstep, voffB); PG8_STAGE(PG8_SA(1, 0), cA + kstep, voffA); PG8_STAGE(PG8_SB(1, 1), cB + hstep + kstep, voffB);
        PG8_WAIT_V(6); PG8_BAR;
    } else {
        PG8_STAGE(PG8_SB(0, 0), cB, voffB); PG8_STAGE(PG8_SA(0, 0), cA, voffA); PG8_STAGE(PG8_SB(0, 1), cB + hstep, voffB); PG8_STAGE(PG8_SA(0, 1), cA + hstep, voffA);
        if (wr == 1) PG8_BAR;
        PG8_WAIT_V(4); PG8_BAR;
        PG8_STAGE(PG8_SB(1, 0), cB + kstep, voffB); PG8_STAGE(PG8_SA(1, 0), cA + kstep, voffA); PG8_STAGE(PG8_SB(1, 1), cB + hstep + kstep, voffB);
        PG8_WAIT_V(6); PG8_BAR;
    }
    for (;;) {
        const bool has_next = S.next(ui + 1, nxt);
        const char* nA = has_next ? (const char*)g.A + (size_t)nxt.pm * tstep : cA; const char* nB = has_next ? (const char*)g.Bt + (size_t)nxt.pn * tstep : cB;
        for (int t = 0; t < nt; t += 2) {
            const bool last = (t == nt - 2);
            const char* a1 = cA + (size_t)(t + 1) * kstep;
            const char* a2 = last ? nA : cA + (size_t)(t + 2) * kstep; const char* b2 = last ? nB : cB + (size_t)(t + 2) * kstep;
            const char* a3 = a2 + kstep; const char* b3 = b2 + kstep;
            if (last && has_next) S.a_ready(nxt);
            if constexpr (SP2) {
            PG8_LDB(B0, 0, 0); PG8_LDB(B1, 0, 1); PG8_SCHED; PG8_LDA(At, 0, 0); PG8_STAGE(PG8_SA(1, 1), a1 + hstep, voffA);
            PG8_WAIT_V(8); PG8_WAIT_L(0); PG8_BAR; PG8_MMA(0, 0, At, B0); PG8_MMA(0, 1, At, B1); PG8_BAR; PG8_SCHED;
            PG8_LDA(At, 0, 1); PG8_STAGE(PG8_SB(0, 0), b2, voffB); PG8_STAGE(PG8_SB(0, 1), b2 + hstep, voffB); PG8_STAGE(PG8_SA(0, 0), a2, voffA);
            PG8_WAIT_V(8); PG8_WAIT_L(0); PG8_BAR; PG8_MMA(1, 0, At, B0); PG8_MMA(1, 1, At, B1); PG8_BAR; PG8_SCHED;
            PG8_LDB(B0, 1, 0); PG8_LDB(B1, 1, 1); PG8_SCHED; PG8_LDA(At, 1, 0); PG8_STAGE(PG8_SA(0, 1), a2 + hstep, voffA);
            PG8_WAIT_V(8); PG8_WAIT_L(0); PG8_BAR; PG8_MMA(0, 0, At, B0); PG8_MMA(0, 1, At, B1); PG8_BAR; PG8_SCHED;
            PG8_LDA(At, 1, 1); PG8_STAGE(PG8_SB(1, 0), b3, voffB); PG8_STAGE(PG8_SB(1, 1), b3 + hstep, voffB); PG8_STAGE(PG8_SA(1, 0), a3, voffA);
            PG8_WAIT_V(8); PG8_WAIT_L(0); PG8_BAR; PG8_MMA(1, 0, At, B0); PG8_MMA(1, 1, At, B1); PG8_BAR; PG8_SCHED;
            } else {
            PG8_LDB(B0, 0, 0); PG8_SCHED; PG8_LDA(At, 0, 0); PG8_STAGE(PG8_SA(1, 1), a1 + hstep, voffA);
            PG8_WAIT_L(8); PG8_BAR; PG8_WAIT_L(0); PG8_MMA(0, 0, At, B0); PG8_BAR; PG8_SCHED;
            PG8_LDB(B1, 0, 1); PG8_STAGE(PG8_SB(0, 0), b2, voffB);
            PG8_BAR; PG8_WAIT_L(0); PG8_MMA(0, 1, At, B1); PG8_BAR;
            PG8_LDA(At, 0, 1); PG8_STAGE(PG8_SA(0, 0), a2, voffA);
            PG8_BAR; PG8_WAIT_L(0); PG8_MMA(1, 0, At, B0); PG8_BAR; PG8_SCHED;
            PG8_STAGE(PG8_SB(0, 1), b2 + hstep, voffB);
            PG8_WAIT_V(6); PG8_BAR; PG8_MMA(1, 1, At, B1); PG8_BAR;
            PG8_LDB(B0, 1, 0); PG8_SCHED; PG8_LDA(At, 1, 0); PG8_STAGE(PG8_SA(0, 1), a2 + hstep, voffA);
            PG8_WAIT_L(8); PG8_BAR; PG8_WAIT_L(0); PG8_MMA(0, 0, At, B0); PG8_BAR; PG8_SCHED;
            PG8_LDB(B1, 1, 1); PG8_STAGE(PG8_SB(1, 0), b3, voffB);
            PG8_BAR; PG8_WAIT_L(0); PG8_MMA(0, 1, At, B1); PG8_BAR;
            PG8_LDA(At, 1, 1); PG8_STAGE(PG8_SA(1, 0), a3, voffA);
            PG8_BAR; PG8_WAIT_L(0); PG8_MMA(1, 0, At, B0); PG8_BAR; PG8_SCHED;
            PG8_STAGE(PG8_SB(1, 1), b3 + hstep, voffB);
            PG8_WAIT_V(6); PG8_BAR; PG8_MMA(1, 1, At, B1); PG8_BAR;
            }
        }
        if constexpr (ALIGN_EPI) { if (wr == 0) PG8_BAR; }
        if constexpr (!Epi::AFTER_DRAIN) { E(acc, cur, wr, wc, fr, fq); S.done(cur); }
        if (!has_next) break;
#pragma unroll
        for (int a = 0; a < 2; ++a)
#pragma unroll
            for (int b = 0; b < 2; ++b)
#pragma unroll
                for (int m = 0; m < 4; ++m)
#pragma unroll
                    for (int n = 0; n < 2; ++n) acc[a][b][m][n] = (f32x4){0.f, 0.f, 0.f, 0.f};
        cur = nxt; cA = nA; cB = nB; ++ui;
        if constexpr (ALIGN_EPI) { if (wr == 1) PG8_BAR; }
    }
    PG8_WAIT_V(0);
    if constexpr (!ALIGN_EPI) { if (wr == 0) PG8_BAR; }
    PG8_BAR;
    if constexpr (Epi::AFTER_DRAIN) { E.fused(acc, cur, wr, wc, fr, fq, lds, wid, lane); S.done(cur); }
#undef PG8_SA
#undef PG8_SB
#undef PG8_STAGE
#undef PG8_LDA
#undef PG8_LDB
#undef PG8_MMA
#undef PG8_WAIT_V
#undef PG8_WAIT_L
#undef PG8_BAR
#undef PG8_SCHED
}
}

#define LAS __attribute__((address_space(3)))
typedef LAS unsigned char lds8;
typedef unsigned short bf16_t;
typedef short bf16x8 __attribute__((ext_vector_type(8)));
typedef short s16x4 __attribute__((ext_vector_type(4)));
typedef float f32x4 __attribute__((ext_vector_type(4)));
typedef float f32x16 __attribute__((ext_vector_type(16)));
typedef unsigned u32x4 __attribute__((ext_vector_type(4)));
typedef unsigned u32x2 __attribute__((ext_vector_type(2)));
typedef float f32x2_t __attribute__((ext_vector_type(2)));
typedef __bf16 bf16x2_t __attribute__((ext_vector_type(2)));

constexpr int DM = 1024, BATCH = 32, SEQ = 2048, MTOK = BATCH * SEQ, DFF = 2816;
constexpr int NCHUNK = 2, CB = BATCH / NCHUNK, MC = CB * SEQ;
constexpr int NIN = 7168;
constexpr float EPSN = 1e-6f;
constexpr float QSCALE = 0.125f * 1.4426950408889634f;
constexpr float NEG = -1e30f;
constexpr size_t MiB = 1u << 20;
constexpr size_t OFF_SSQ = 0;
constexpr size_t OFF_ROPE = 1 * MiB, OFF_BAR = 1 * MiB + 512 * 1024;
constexpr size_t OFF_W13_1 = 2 * MiB, OFF_W2_1 = 14 * MiB, OFF_W13_2 = 20 * MiB, OFF_W2_2 = 32 * MiB, OFF_WIN = 38 * MiB;
constexpr size_t OFF_WPD = 52 * MiB, OFF_WPN = 54 * MiB, OFF_WOUT = 56 * MiB, OFF_W1C = 58 * MiB;
constexpr size_t OFF_XB = 64 * MiB;
constexpr size_t OFF_BIG = 192 * MiB;
constexpr size_t OFF_QDA = OFF_BIG, OFF_KDA = OFF_QDA + 64 * MiB, OFF_VDA = OFF_KDA + 64 * MiB, OFF_QNS = OFF_VDA + 64 * MiB;
constexpr size_t OFF_GA = OFF_QNS + 64 * MiB, OFF_GB = OFF_GA + 64 * MiB, OFF_MRG = OFF_GB + 64 * MiB;
constexpr size_t OFF_KVC = OFF_MRG + 64 * MiB, OFF_KSW = OFF_KVC + 16 * MiB, OFF_VSW = OFF_KSW + 16 * MiB, OFF_GNS = OFF_VSW + 16 * MiB;
constexpr size_t OFF_ABLK = OFF_GNS + 4 * MiB, OFF_HID = OFF_ABLK + 32 * MiB, OFF_KC = OFF_HID + 4 * MiB, OFF_VC = OFF_KC + 1 * MiB;
constexpr size_t OFF_YDA = OFF_VC + 1 * MiB, OFF_YNS = OFF_YDA + 64 * MiB;
constexpr size_t WS_END = OFF_YNS + 64 * MiB;
static_assert(OFF_BIG + (size_t)MTOK * DFF * 2 <= 1024 * MiB && WS_END <= 1024 * MiB, "ws map");

__constant__ float c_invfreq[32] = {1.000000000e+00f, 7.498942018e-01f, 5.623413324e-01f, 4.216965139e-01f, 3.162277639e-01f, 2.371373922e-01f, 1.778279394e-01f, 1.333521456e-01f, 1.000000015e-01f, 7.498941571e-02f, 5.623412877e-02f, 4.216964915e-02f, 3.162277862e-02f, 2.371373586e-02f, 1.778279431e-02f, 1.333521493e-02f, 9.999999776e-03f, 7.498942316e-03f, 5.623413250e-03f, 4.216964822e-03f, 3.162277862e-03f, 2.371373819e-03f, 1.778279431e-03f, 1.333521446e-03f, 1.000000047e-03f, 7.498941850e-04f, 5.623413017e-04f, 4.216965463e-04f, 3.162277862e-04f, 2.371373848e-04f, 1.778279402e-04f, 1.333521504e-04f};

#define DI __device__ __forceinline__
DI unsigned cvtpk(float lo, float hi) { f32x2_t v = {lo, hi}; bf16x2_t b = __builtin_convertvector(v, bf16x2_t); return __builtin_bit_cast(unsigned, b); }
DI float bf2f(unsigned short u) { return __uint_as_float(((unsigned)u) << 16); }
DI float bflo(unsigned w) { return __uint_as_float(w << 16); }
DI float bfhi(unsigned w) { return __uint_as_float(w & 0xffff0000u); }
DI float sigmoidf_(float v) { return __builtin_amdgcn_rcpf(1.f + __builtin_amdgcn_exp2f(-v * 1.4426950408889634f)); }
DI u32x4 pack8(f32x4 a, f32x4 b) { u32x4 w; w.x = cvtpk(a[0], a[1]); w.y = cvtpk(a[2], a[3]); w.z = cvtpk(b[0], b[1]); w.w = cvtpk(b[2], b[3]); return w; }
DI int crow(int i, int h) { return (i & 3) + 8 * (i >> 2) + 4 * h; }
#define MFMA32(a, b, c) __builtin_amdgcn_mfma_f32_32x32x16_bf16((a), (b), (c), 0, 0, 0)

struct Params {
  const float *x, *ffn1_norm, *ffn1_w1, *ffn1_w3, *ffn1_w2, *mix_norm, *w_in, *da_lambda, *da_head_norm, *cmp_pos, *cmp_w1, *cmp_w2,
      *w_proj_da, *w_proj_nsa, *w_out, *ffn2_norm, *ffn2_w1, *ffn2_w3, *ffn2_w2, *final_norm;
  float* out; unsigned char* ws;
};

using pg8::Unit;
struct EpiSwiGLU {
  static constexpr bool PERM = true, AFTER_DRAIN = false;
  bf16_t* H; const float* ssq;
  DI void operator()(const f32x4 (&acc)[2][2][4][2], const Unit& u, int wr, int wc, int fr, int fq) const {
    const int row0 = u.pm * 256 + wr * 64 + fr; const int hcol = u.pn * 128 + wc * 32 + 8 * fq;
    float rs[8];
#pragma unroll
    for (int i = 0; i < 8; ++i) rs[i] = ssq[row0 + (i >> 2) * 128 + (i & 3) * 16];
#pragma unroll
    for (int ai = 0; ai < 2; ++ai)
#pragma unroll
      for (int m = 0; m < 4; ++m) {
        const int row = row0 + ai * 128 + m * 16;
        const float rstd = rsqrtf(rs[ai * 4 + m] * (1.f / DM) + EPSN);
        f32x4 o[2];
#pragma unroll
        for (int n = 0; n < 2; ++n) {
          const f32x4 a = acc[ai][0][m][n] * rstd, b = acc[ai][1][m][n] * rstd;
#pragma unroll
          for (int e = 0; e < 4; ++e) o[n][e] = a[e] * sigmoidf_(a[e]) * b[e];
        }
        __builtin_nontemporal_store(pack8(o[0], o[1]), (u32x4*)(H + (size_t)row * DFF + hcol));
      }
  }
};
struct EpiResid {
  static constexpr bool PERM = true, AFTER_DRAIN = false;
  const bf16_t* xin_b; bf16_t* xb; float* ssq_out; float scale; int row_off;
  DI void operator()(const f32x4 (&acc)[2][2][4][2], const Unit& u, int wr, int wc, int fr, int fq) const {
    const int row0 = row_off + u.pm * 256 + wr * 64 + fr; const int col0 = u.pn * 256 + wc * 32 + 8 * fq;
#pragma unroll
    for (int ai = 0; ai < 2; ++ai) {
      u32x4 xv[4][2];
#pragma unroll
      for (int m = 0; m < 4; ++m)
#pragma unroll
        for (int bj = 0; bj < 2; ++bj) xv[m][bj] = *(const u32x4*)(xin_b + (size_t)(row0 + ai * 128 + m * 16) * DM + col0 + bj * 128);
      asm volatile("" ::: "memory");
#pragma unroll
      for (int m = 0; m < 4; ++m) {
        const int row = row0 + ai * 128 + m * 16; float s = 0.f;
#pragma unroll
        for (int bj = 0; bj < 2; ++bj) {
          const size_t off = (size_t)row * DM + col0 + bj * 128;
          const u32x4 v = xv[m][bj];
          const f32x4 x0 = {bflo(v.x), bfhi(v.x), bflo(v.y), bfhi(v.y)}, x1 = {bflo(v.z), bfhi(v.z), bflo(v.w), bfhi(v.w)};
          const f32x4 y0 = x0 + acc[ai][bj][m][0] * scale, y1 = x1 + acc[ai][bj][m][1] * scale;
          *(u32x4*)(xb + off) = pack8(y0, y1);
          s += (y0[0] * y0[0] + y0[1] * y0[1]) + (y0[2] * y0[2] + y0[3] * y0[3]) + (y1[0] * y1[0] + y1[1] * y1[1]) + (y1[2] * y1[2] + y1[3] * y1[3]);
        }
        s += __shfl_xor(s, 16); s += __shfl_xor(s, 32);
        if (fq == 0) atomicAdd(ssq_out + row, s);
      }
      asm volatile("" ::: "memory");
    }
  }
};
struct EpiWin {
  static constexpr bool PERM = true, AFTER_DRAIN = false;
  const float* ssq; int row_off; const float* rope;
  bf16_t *QDA, *KDA, *VDA, *QNS, *KVC, *KSW, *VSW, *GNS, *GA, *GB;
  DI void operator()(const f32x4 (&acc)[2][2][4][2], const Unit& u, int wr, int wc, int fr, int fq) const {
    const int tl = u.pn; const int rowl0 = u.pm * 256 + wr * 64 + fr; const int c8 = wc * 32 + 8 * fq;
    if (tl < 8 || tl == 17) {
      bf16_t* dst; int colbase, pitch; float sc = 1.f;
      if (tl < 4) { dst = QDA; colbase = (tl * 4 + wc) * 64; pitch = DM; sc = QSCALE; }
      else if (tl < 8) { dst = KDA; colbase = ((tl - 4) * 4 + wc) * 64; pitch = DM; }
      else { dst = KSW; colbase = wc * 64; pitch = 256; }
#pragma unroll
      for (int ai = 0; ai < 2; ++ai)
#pragma unroll
        for (int m = 0; m < 4; ++m) {
          const int rowl = rowl0 + ai * 128 + m * 16; const int t = rowl & (SEQ - 1);
          const float rstd = rsqrtf(ssq[row_off + rowl] * (1.f / DM) + EPSN) * sc;
          const float* rc = rope + t * 32 + 8 * fq;
          const f32x4 c0 = *(const f32x4*)(rc), c1 = *(const f32x4*)(rc + 4), s0 = *(const f32x4*)(rc + 65536), s1 = *(const f32x4*)(rc + 65536 + 4);
          const f32x4 x1a = acc[ai][0][m][0] * rstd, x1b = acc[ai][0][m][1] * rstd, x2a = acc[ai][1][m][0] * rstd, x2b = acc[ai][1][m][1] * rstd;
          const f32x4 o1a = x1a * c0 - x2a * s0, o1b = x1b * c1 - x2b * s1, o2a = x2a * c0 + x1a * s0, o2b = x2b * c1 + x1b * s1;
          bf16_t* d = dst + (size_t)rowl * pitch + colbase + 8 * fq;
          *(u32x4*)(d) = pack8(o1a, o1b); *(u32x4*)(d + 32) = pack8(o2a, o2b);
          asm volatile("" ::: "memory");
        }
    } else {
      bf16_t* dst; int coloff = 0, pitch = DM, mode = 0;
      if (tl < 12) { dst = VDA; coloff = (tl - 8) * 256; }
      else if (tl < 16) { dst = QNS; coloff = (tl - 12) * 256; mode = 1; }
      else if (tl == 16) { dst = KVC; pitch = 256; }
      else if (tl == 18) { dst = VSW; pitch = 256; }
      else if (tl == 19) { dst = GNS; pitch = 64; mode = 2; }
      else if (tl < 24) { dst = GA; coloff = (tl - 20) * 256; mode = 2; }
      else { dst = GB; coloff = (tl - 24) * 256; mode = 2; }
#pragma unroll
      for (int ai = 0; ai < 2; ++ai)
#pragma unroll
        for (int m = 0; m < 4; ++m) {
          const int rowl = rowl0 + ai * 128 + m * 16;
          const float rstd = rsqrtf(ssq[row_off + rowl] * (1.f / DM) + EPSN) * (mode == 1 ? QSCALE : 1.f);
#pragma unroll
          for (int bj = 0; bj < 2; ++bj) {
            const int col = bj * 128 + c8;
            if (tl == 19 && col >= 64) continue;
            f32x4 v0 = acc[ai][bj][m][0] * rstd, v1 = acc[ai][bj][m][1] * rstd;
            if (mode == 2) {
#pragma unroll
              for (int e = 0; e < 4; ++e) { v0[e] = sigmoidf_(v0[e]); v1[e] = sigmoidf_(v1[e]); }
            }
            if (tl >= 20) __builtin_nontemporal_store(pack8(v0, v1), (u32x4*)(dst + (size_t)rowl * pitch + coloff + col));
            else *(u32x4*)(dst + (size_t)rowl * pitch + coloff + col) = pack8(v0, v1);
          }
        }
    }
  }
};
struct EpiGelu {
  static constexpr bool PERM = true, AFTER_DRAIN = false;
  bf16_t* HID;
  DI void operator()(const f32x4 (&acc)[2][2][4][2], const Unit& u, int wr, int wc, int fr, int fq) const {
    const int row0 = u.pm * 256 + wr * 64 + fr; const int c8 = wc * 32 + 8 * fq;
#pragma unroll
    for (int ai = 0; ai < 2; ++ai)
#pragma unroll
      for (int m = 0; m < 4; ++m)
#pragma unroll
        for (int bj = 0; bj < 2; ++bj) {
          f32x4 v[2];
#pragma unroll
          for (int n = 0; n < 2; ++n)
#pragma unroll
            for (int e = 0; e < 4; ++e) { const float a = acc[ai][bj][m][n][e]; const float z = 0.7978845608028654f * (a + 0.044715f * a * a * a); v[n][e] = a * sigmoidf_(2.f * z); }
          *(u32x4*)(HID + (size_t)(row0 + ai * 128 + m * 16) * 256 + bj * 128 + c8) = pack8(v[0], v[1]);
          asm volatile("" ::: "memory");
        }
  }
};
template <int STEP> struct EpiMerge {
  static constexpr bool PERM = true, AFTER_DRAIN = false;
  const bf16_t* gate; bf16_t* MRG;
  DI void operator()(const f32x4 (&acc)[2][2][4][2], const Unit& u, int wr, int wc, int fr, int fq) const {
    const int row0 = u.pm * 256 + wr * 64 + fr; const int col0 = u.pn * 256 + wc * 32 + 8 * fq;
#pragma unroll
    for (int ai = 0; ai < 2; ++ai) {
      u32x4 gv[4][2];
#pragma unroll
      for (int m = 0; m < 4; ++m)
#pragma unroll
        for (int bj = 0; bj < 2; ++bj) gv[m][bj] = *(const u32x4*)(gate + (size_t)(row0 + ai * 128 + m * 16) * DM + col0 + bj * 128);
#pragma unroll
      for (int mb = 0; mb < 4; mb += 2) {
        u32x4 pv[2][2];
        if (STEP == 1) {
#pragma unroll
          for (int mm = 0; mm < 2; ++mm)
#pragma unroll
            for (int bj = 0; bj < 2; ++bj) pv[mm][bj] = *(const u32x4*)(MRG + (size_t)(row0 + ai * 128 + (mb + mm) * 16) * DM + col0 + bj * 128);
        }
        asm volatile("" ::: "memory");
#pragma unroll
        for (int mm = 0; mm < 2; ++mm)
#pragma unroll
          for (int bj = 0; bj < 2; ++bj) {
            const int m = mb + mm;
            const size_t off = (size_t)(row0 + ai * 128 + m * 16) * DM + col0 + bj * 128;
            const u32x4 g = gv[m][bj];
            f32x4 v0 = acc[ai][bj][m][0], v1 = acc[ai][bj][m][1];
            v0[0] *= bflo(g.x); v0[1] *= bfhi(g.x); v0[2] *= bflo(g.y); v0[3] *= bfhi(g.y); v1[0] *= bflo(g.z); v1[1] *= bfhi(g.z); v1[2] *= bflo(g.w); v1[3] *= bfhi(g.w);
            if (STEP == 1) { const u32x4 p = pv[mm][bj];
              v0[0] += bflo(p.x); v0[1] += bfhi(p.x); v0[2] += bflo(p.y); v0[3] += bfhi(p.y); v1[0] += bflo(p.z); v1[1] += bfhi(p.z); v1[2] += bflo(p.w); v1[3] += bfhi(p.w); }
            *(u32x4*)(MRG + off) = pack8(v0, v1);
          }
        asm volatile("" ::: "memory");
      }
    }
  }
};
struct PanelOrder {
  int G, c;
  DI bool next(int i, Unit& u) const { const int pm = c + (i >> 2) * G; if (pm >= MTOK / 256) return false; u.pm = pm; u.pn = i & 3; return true; }
  DI void a_ready(const Unit&) const {}
  DI void done(const Unit&) const {}
};
struct CmpOrder {
  int c;
  DI bool next(int i, Unit& u) const { if (i > 0 || c >= 32) return false; u.pm = c; u.pn = c >> 4; return true; }
  DI void a_ready(const Unit&) const {}
  DI void done(const Unit&) const {}
};

DI void conv_item(const float* W, int ldw, int srccol0, const float* gain, int K, bf16_t* WT, int n0, int k0, LAS float* scr, int lane) {
  float vv[32];
#pragma unroll
  for (int i = 0; i < 32; ++i) { const int kk = 2 * i + (lane >> 5); vv[i] = W ? W[(size_t)(k0 + kk) * ldw + srccol0 + (lane & 31)] : 0.f; }
  if (gain) {
#pragma unroll
    for (int i = 0; i < 32; ++i) vv[i] *= gain[k0 + 2 * i + (lane >> 5)];
  }
#pragma unroll
  for (int i = 0; i < 32; ++i) scr[(2 * i + (lane >> 5)) * 33 + (lane & 31)] = vv[i];
  asm volatile("s_waitcnt lgkmcnt(0)" ::: "memory");
  const int c = lane & 7;
#pragma unroll
  for (int j = 0; j < 4; ++j) { const int n = (lane >> 3) + 8 * j; const LAS float* s = scr + (8 * c) * 33 + n;
    u32x4 o; o.x = cvtpk(s[0 * 33], s[1 * 33]); o.y = cvtpk(s[2 * 33], s[3 * 33]); o.z = cvtpk(s[4 * 33], s[5 * 33]); o.w = cvtpk(s[6 * 33], s[7 * 33]);
    *(u32x4*)(WT + (size_t)(n0 + n) * K + k0 + 8 * c) = o; }
  asm volatile("s_waitcnt lgkmcnt(0)" ::: "memory");
}
DI int win_src(int n0) {
  const int tl = n0 >> 8, j = n0 & 255;
  if (tl < 8 || (tl >= 12 && tl < 16)) {
    if (tl >= 12) return 3072 + (tl - 12) * 256 + j;
    const int base = (tl < 4) ? 0 : 1024; const int lt = tl & 3;
    return base + lt * 256 + ((j & 127) >> 5) * 64 + (j >> 7) * 32;
  }
  if (tl < 12) return 2048 + (tl - 8) * 256 + j;
  if (tl == 16) return 4096 + j;
  if (tl == 17) { const int hm = (j & 127) >> 5; const int b = (hm < 2) ? 4352 + hm * 64 : 4608 + (hm - 2) * 64; return b + (j >> 7) * 32; }
  if (tl == 18) return (j < 128) ? 4480 + j : 4736 + (j - 128);
  if (tl == 19) return (j < 64) ? 4864 + j : -1;
  if (tl < 24) return 4912 + (tl - 20) * 256 + j;
  return 5936 + (tl - 24) * 256 + j;
}
DI void prologue(const Params& p, lds8* lds, int NGW) {
  int tid = threadIdx.x; asm volatile("" : "+v"(tid));
  const int lane = tid & 63, wid = __builtin_amdgcn_readfirstlane(tid >> 6); const int gw = blockIdx.x * 8 + wid;
  unsigned char* ws = p.ws;
  LAS float* scr = (LAS float*)(lds + wid * 8704);
  constexpr int I13 = 16 * 176, I2 = 44 * 32, IWIN = 16 * 224, IP = 16 * 32, IC = 32 * 8;
  constexpr int NITEMS = 2 * I13 + 2 * I2 + IWIN + 3 * IP + 2 * IC;
  for (int it = gw; it < NITEMS; it += NGW) {
    int r = it;
    if (r < 2 * I13) { const int f = r / I13; r -= f * I13; const int kb = r / 176, nb = r % 176, n0 = nb * 32; const int tp = n0 >> 8, j = n0 & 255;
      const float* W = f ? (j < 128 ? p.ffn2_w1 : p.ffn2_w3) : (j < 128 ? p.ffn1_w1 : p.ffn1_w3);
      conv_item(W, DFF, tp * 128 + (j & 127), f ? p.ffn2_norm : p.ffn1_norm, DM, (bf16_t*)(ws + (f ? OFF_W13_2 : OFF_W13_1)), n0, kb * 64, scr, lane); continue; }
    r -= 2 * I13;
    if (r < 2 * I2) { const int f = r / I2; r -= f * I2; const int kb = r / 32, nb = r % 32;
      conv_item(f ? p.ffn2_w2 : p.ffn1_w2, DM, nb * 32, nullptr, DFF, (bf16_t*)(ws + (f ? OFF_W2_2 : OFF_W2_1)), nb * 32, kb * 64, scr, lane); continue; }
    r -= 2 * I2;
    if (r < IWIN) { const int kb = r / 224, nb = r % 224; const int sc = win_src(nb * 32);
      conv_item(sc >= 0 ? p.w_in : nullptr, 6960, sc, p.mix_norm, DM, (bf16_t*)(ws + OFF_WIN), nb * 32, kb * 64, scr, lane); continue; }
    r -= IWIN;
    if (r < 3 * IP) { const int f = r / IP; r -= f * IP; const int kb = r / 32, nb = r % 32;
      conv_item(f == 0 ? p.w_proj_da : (f == 1 ? p.w_proj_nsa : p.w_out), DM, nb * 32, nullptr, DM, (bf16_t*)(ws + (f == 0 ? OFF_WPD : (f == 1 ? OFF_WPN : OFF_WOUT))), nb * 32, kb * 64, scr, lane); continue; }
    r -= 3 * IP;
    { const int f = r / IC; r -= f * IC; const int kb = r / 8, nb = r % 8;
      conv_item(p.cmp_w1 + (size_t)f * 2048 * 256, 256, nb * 32, nullptr, 2048, (bf16_t*)(ws + OFF_W1C) + (size_t)f * 256 * 2048, nb * 32, kb * 64, scr, lane); }
  }
  float* ssq = (float*)(ws + OFF_SSQ); bf16_t* XB = (bf16_t*)(ws + OFF_XB);
  for (int m = gw; m < MTOK; m += 2 * NGW) {
    const int m2 = m + NGW; const bool has2 = m2 < MTOK;
    const f32x4* xr = (const f32x4*)(p.x + (size_t)m * DM) + lane; const f32x4* xr2 = (const f32x4*)(p.x + (size_t)(has2 ? m2 : m) * DM) + lane;
    f32x4 v[4], w[4];
#pragma unroll
    for (int j = 0; j < 4; ++j) { v[j] = __builtin_nontemporal_load(&xr[64 * j]); w[j] = __builtin_nontemporal_load(&xr2[64 * j]); }
    float s = 0.f, s2 = 0.f;
    u32x2* o8 = (u32x2*)(XB + (size_t)m * DM) + lane; u32x2* o82 = (u32x2*)(XB + (size_t)m2 * DM) + lane;
#pragma unroll
    for (int j = 0; j < 4; ++j) { s += (v[j][0] * v[j][0] + v[j][1] * v[j][1]) + (v[j][2] * v[j][2] + v[j][3] * v[j][3]); u32x2 o; o.x = cvtpk(v[j][0], v[j][1]); o.y = cvtpk(v[j][2], v[j][3]); o8[64 * j] = o;
      s2 += (w[j][0] * w[j][0] + w[j][1] * w[j][1]) + (w[j][2] * w[j][2] + w[j][3] * w[j][3]); if (has2) { u32x2 o2; o2.x = cvtpk(w[j][0], w[j][1]); o2.y = cvtpk(w[j][2], w[j][3]); o82[64 * j] = o2; } }
#pragma unroll
    for (int o = 1; o < 64; o <<= 1) { s += __shfl_xor(s, o); s2 += __shfl_xor(s2, o); }
    if (lane == 0) { ssq[m] = s; ssq[MTOK + m] = 0.f; ssq[2 * MTOK + m] = 0.f; ssq[3 * MTOK + m] = 0.f;
      if (has2) { ssq[m2] = s2; ssq[MTOK + m2] = 0.f; ssq[2 * MTOK + m2] = 0.f; ssq[3 * MTOK + m2] = 0.f; } }
  }
  float* rope = (float*)(ws + OFF_ROPE);
  for (int idx = gw * 64 + lane; idx < SEQ * 32; idx += NGW * 64) {
    const int t = idx >> 5, i = idx & 31;
    const float ang = (float)t * c_invfreq[i];
    const double ad = (double)ang; const double k = rint(ad * 0.15915494309189535); const float rr = (float)(ad - k * 6.283185307179586);
    rope[idx] = __cosf(rr); rope[65536 + idx] = __sinf(rr);
  }
}

#define SBAR() __builtin_amdgcn_sched_barrier(0)
template <int KSTR> DI void qk64(f32x16& s0, f32x16& s1, const lds8* kp, const bf16x8 (&q)[4]) {
  bf16x8 a[8];
#pragma unroll
  for (int ks = 0; ks < 4; ++ks) { a[2 * ks] = *(const LAS bf16x8*)(kp + ks * 32); a[2 * ks + 1] = *(const LAS bf16x8*)(kp + 32 * KSTR + ks * 32); }
#pragma unroll
  for (int i = 0; i < 16; ++i) { s0[i] = 0.f; s1[i] = 0.f; }
  SBAR();
  __builtin_amdgcn_s_setprio(1);
#pragma unroll
  for (int ks = 0; ks < 4; ++ks) { s0 = MFMA32(a[2 * ks], q[ks], s0); s1 = MFMA32(a[2 * ks + 1], q[ks], s1); }
  __builtin_amdgcn_s_setprio(0);
  SBAR();
}
DI s16x4 trrd(const lds8* p) { typedef short v4i16_t __attribute__((ext_vector_type(4))); return __builtin_bit_cast(s16x4, __builtin_amdgcn_ds_read_tr16_b64_v4i16((LAS v4i16_t*)p)); }
template <int VSTR, int NDVB> DI void pv64(f32x16 (&O)[NDVB], const lds8* vp, const bf16x8 (&P)[4]) {
  bf16x8 f[2][NDVB];
#pragma unroll
  for (int d = 0; d < NDVB; ++d) { const s16x4 lo = trrd(vp + d * 64), hi = trrd(vp + 8 * VSTR + d * 64); f[0][d] = __builtin_shufflevector(lo, hi, 0, 1, 2, 3, 4, 5, 6, 7); }
#pragma unroll
  for (int kk = 0; kk < 4; ++kk) {
    if (kk < 3) {
#pragma unroll
      for (int d = 0; d < NDVB; ++d) { const s16x4 lo = trrd(vp + (16 * (kk + 1)) * VSTR + d * 64), hi = trrd(vp + (16 * (kk + 1) + 8) * VSTR + d * 64);
        f[(kk + 1) & 1][d] = __builtin_shufflevector(lo, hi, 0, 1, 2, 3, 4, 5, 6, 7); }
    }
    SBAR();
    __builtin_amdgcn_s_setprio(1);
#pragma unroll
    for (int d = 0; d < NDVB; ++d) O[d] = MFMA32(f[kk & 1][d], P[kk], O[d]);
    __builtin_amdgcn_s_setprio(0);
    SBAR();
  }
}
DI float softmax_step(f32x16& s0, f32x16& s1, float& m, float& l, bf16x8 (&P)[4]) {
  float mx = fmaxf(s0[0], s1[0]);
#pragma unroll
  for (int i = 1; i < 16; ++i) mx = fmaxf(mx, fmaxf(s0[i], s1[i]));
  mx = fmaxf(mx, __shfl_xor(mx, 32));
  const float mnew = fmaxf(m, mx); const float muse = (mnew < -1e29f) ? 0.f : mnew;
  const float alpha = __builtin_amdgcn_exp2f(m - muse);
  m = mnew; float sum = 0.f;
#pragma unroll
  for (int i = 0; i < 16; ++i) { s0[i] = __builtin_amdgcn_exp2f(s0[i] - muse); s1[i] = __builtin_amdgcn_exp2f(s1[i] - muse); sum += s0[i] + s1[i]; }
  l = l * alpha + sum;
  u32x4 w;
  w.x = cvtpk(s0[0], s0[1]); w.y = cvtpk(s0[2], s0[3]); w.z = cvtpk(s0[4], s0[5]); w.w = cvtpk(s0[6], s0[7]); P[0] = __builtin_bit_cast(bf16x8, w);
  w.x = cvtpk(s0[8], s0[9]); w.y = cvtpk(s0[10], s0[11]); w.z = cvtpk(s0[12], s0[13]); w.w = cvtpk(s0[14], s0[15]); P[1] = __builtin_bit_cast(bf16x8, w);
  w.x = cvtpk(s1[0], s1[1]); w.y = cvtpk(s1[2], s1[3]); w.z = cvtpk(s1[4], s1[5]); w.w = cvtpk(s1[6], s1[7]); P[2] = __builtin_bit_cast(bf16x8, w);
  w.x = cvtpk(s1[8], s1[9]); w.y = cvtpk(s1[10], s1[11]); w.z = cvtpk(s1[12], s1[13]); w.w = cvtpk(s1[14], s1[15]); P[3] = __builtin_bit_cast(bf16x8, w);
  return alpha;
}

constexpr int DA_KSTR = 304, DA_STAGE = 2 * 64 * DA_KSTR;
template <int KSTR> DI void qk64b(f32x16& s0, f32x16& s1, const lds8* kp, const bf16x8 (&q)[4], float bias) {
  bf16x8 a[8];
#pragma unroll
  for (int ks = 0; ks < 4; ++ks) { a[2 * ks] = *(const LAS bf16x8*)(kp + ks * 32); a[2 * ks + 1] = *(const LAS bf16x8*)(kp + 32 * KSTR + ks * 32); }
#pragma unroll
  for (int i = 0; i < 16; ++i) { s0[i] = bias; s1[i] = bias; }
  SBAR();
  __builtin_amdgcn_s_setprio(1);
#pragma unroll
  for (int ks = 0; ks < 4; ++ks) { s0 = MFMA32(a[2 * ks], q[ks], s0); s1 = MFMA32(a[2 * ks + 1], q[ks], s1); }
  __builtin_amdgcn_s_setprio(0);
  SBAR();
}
template <int KSTR> DI void qk64c(f32x16& s0, f32x16& s1, const lds8* kp, const bf16x8 (&q)[4], const f32x16& negm) {
  bf16x8 a[8];
#pragma unroll
  for (int ks = 0; ks < 4; ++ks) { a[2 * ks] = *(const LAS bf16x8*)(kp + ks * 32); a[2 * ks + 1] = *(const LAS bf16x8*)(kp + 32 * KSTR + ks * 32); }
  SBAR();
  __builtin_amdgcn_s_setprio(1);
  s0 = MFMA32(a[0], q[0], negm); s1 = MFMA32(a[1], q[0], negm);
#pragma unroll
  for (int ks = 1; ks < 4; ++ks) { s0 = MFMA32(a[2 * ks], q[ks], s0); s1 = MFMA32(a[2 * ks + 1], q[ks], s1); }
  __builtin_amdgcn_s_setprio(0);
  SBAR();
}
DI float rowmax32(const f32x16& s0, const f32x16& s1) {
  float a = fmaxf(fmaxf(s0[0], s0[1]), s1[0]), b = fmaxf(fmaxf(s0[2], s0[3]), s1[1]); a = fmaxf(fmaxf(a, s1[2]), s1[3]);
#pragma unroll
  for (int r = 4; r < 16; r += 4) { a = fmaxf(fmaxf(a, s0[r]), s0[r + 1]); b = fmaxf(fmaxf(b, s0[r + 2]), s0[r + 3]); a = fmaxf(fmaxf(a, s1[r]), s1[r + 1]); b = fmaxf(fmaxf(b, s1[r + 2]), s1[r + 3]); }
  const float m = fmaxf(a, b);
  return fmaxf(m, __shfl_xor(m, 32));
}
template <int NDVB, bool HAS_NEXT> DI void softmax_def(f32x16& sa0, f32x16& sa1, f32x16& sb0, f32x16& sb1, f32x16 (&O)[NDVB], float& muse, float& l, bool first, bf16x8 (&P)[4], bool check = true) {
  float mx = 0.f;
  if (check) mx = rowmax32(sa0, sa1);
  if (check && (first || __any(mx > 8.f))) {
    float dl = first ? mx : fmaxf(mx, 0.f);
    if (mx < -1e29f) dl = 0.f;
    const float alpha = __builtin_amdgcn_exp2f(-dl);
    muse += dl; l *= alpha;
#pragma unroll
    for (int i = 0; i < 16; ++i) { sa0[i] -= dl; sa1[i] -= dl; }
    if (HAS_NEXT) {
#pragma unroll
      for (int i = 0; i < 16; ++i) { sb0[i] -= dl; sb1[i] -= dl; }
    }
#pragma unroll
    for (int d = 0; d < NDVB; ++d)
#pragma unroll
      for (int i = 0; i < 16; ++i) O[d][i] *= alpha;
  }
  float sum = 0.f;
#pragma unroll
  for (int i = 0; i < 16; ++i) { sa0[i] = __builtin_amdgcn_exp2f(sa0[i]); sum += sa0[i]; }
#pragma unroll
  for (int i = 0; i < 16; ++i) { sa1[i] = __builtin_amdgcn_exp2f(sa1[i]); sum += sa1[i]; }
  l += sum;
  u32x4 w;
  w.x = cvtpk(sa0[0], sa0[1]); w.y = cvtpk(sa0[2], sa0[3]); w.z = cvtpk(sa0[4], sa0[5]); w.w = cvtpk(sa0[6], sa0[7]); P[0] = __builtin_bit_cast(bf16x8, w);
  w.x = cvtpk(sa0[8], sa0[9]); w.y = cvtpk(sa0[10], sa0[11]); w.z = cvtpk(sa0[12], sa0[13]); w.w = cvtpk(sa0[14], sa0[15]); P[1] = __builtin_bit_cast(bf16x8, w);
  w.x = cvtpk(sa1[0], sa1[1]); w.y = cvtpk(sa1[2], sa1[3]); w.z = cvtpk(sa1[4], sa1[5]); w.w = cvtpk(sa1[6], sa1[7]); P[2] = __builtin_bit_cast(bf16x8, w);
  w.x = cvtpk(sa1[8], sa1[9]); w.y = cvtpk(sa1[10], sa1[11]); w.z = cvtpk(sa1[12], sa1[13]); w.w = cvtpk(sa1[14], sa1[15]); P[3] = __builtin_bit_cast(bf16x8, w);
}
struct DaCtx { const bf16_t* kg; const bf16_t* vg; int sr0, sc0, sr1, sc1, koff, voff, qpos, h, qs, q0; };
template <bool LOAD2, bool MASK>
DI void da_step(lds8* lds, const DaCtx& cx, int t, const bf16x8 (&q)[4], f32x16 (&O)[4], float& muse, float& l, f32x16& negm) {
  u32x4 kr0, kr1, vr0, vr1;
  if (LOAD2) { const size_t ro = (size_t)(t + 2) * 64;
    kr0 = *(const u32x4*)(cx.kg + (ro + cx.sr0) * DM + cx.sc0 * 8); kr1 = *(const u32x4*)(cx.kg + (ro + cx.sr1) * DM + cx.sc1 * 8);
    vr0 = *(const u32x4*)(cx.vg + (ro + cx.sr0) * DM + cx.sc0 * 8); vr1 = *(const u32x4*)(cx.vg + (ro + cx.sr1) * DM + cx.sc1 * 8); }
  SBAR();
  const int st = t % 3, stn2 = (st == 0) ? 2 : st - 1;
  const bool cur_live = !MASK || 64 * t <= cx.q0 + 32 * cx.qs + 31;
  if (cur_live) {
    f32x16 sa0, sa1, du0, du1;
    qk64c<DA_KSTR>(sa0, sa1, lds + st * DA_STAGE + cx.koff, q, negm);
    if (MASK) {
      if (64 * t + 63 > cx.q0 + 32 * cx.qs) {
#pragma unroll
        for (int i = 0; i < 16; ++i) { const int key = 64 * t + crow(i, cx.h); if (key > cx.qpos) sa0[i] = NEG; if (key + 32 > cx.qpos) sa1[i] = NEG; }
      }
    }
    bf16x8 P[4];
    const float mprev = muse;
    softmax_def<4, false>(sa0, sa1, du0, du1, O, muse, l, t == 0, P, MASK || (t & 1) == 0);
    if (__any(muse != mprev)) {
#pragma unroll
      for (int i = 0; i < 16; ++i) negm[i] = -muse;
    }
    pv64<DA_KSTR, 4>(O, lds + st * DA_STAGE + cx.voff, P);
  }
  if (LOAD2) { lds8* b = lds + stn2 * DA_STAGE;
    *(LAS u32x4*)(b + cx.sr0 * DA_KSTR + cx.sc0 * 16) = kr0; *(LAS u32x4*)(b + cx.sr1 * DA_KSTR + cx.sc1 * 16) = kr1;
    *(LAS u32x4*)(b + 64 * DA_KSTR + cx.sr0 * DA_KSTR + cx.sc0 * 16) = vr0; *(LAS u32x4*)(b + 64 * DA_KSTR + cx.sr1 * DA_KSTR + cx.sc1 * 16) = vr1;
    __syncthreads(); }
}
DI void da_unit(const Params& p, lds8* lds, int bl, int hd, int qb, float lam) {
  int tid = threadIdx.x; asm volatile("" : "+v"(tid));
  const int lane = tid & 63, wid = __builtin_amdgcn_readfirstlane(tid >> 6);
  unsigned char* ws = p.ws;
  bf16_t* QDA = (bf16_t*)(ws + OFF_QDA); const bf16_t* KDA = (const bf16_t*)(ws + OFF_KDA); const bf16_t* VDA = (const bf16_t*)(ws + OFF_VDA);
  const int r = lane & 31, h = lane >> 5, qs = wid & 3, c = wid >> 2;
  const size_t rowbase = (size_t)bl * SEQ; const int q0 = qb * 128; const int qpos = q0 + 32 * qs + r;
  bf16x8 q[4];
  { const bf16_t* qp = QDA + (rowbase + qpos) * DM + hd * 128 + c * 64 + 8 * h;
#pragma unroll
    for (int ks = 0; ks < 4; ++ks) q[ks] = *(const bf16x8*)(qp + 16 * ks); }
  const int nt = 2 * (qb + 1);
  DaCtx cx;
  { const int ch0 = tid, ch1 = tid + 512; cx.sr0 = ch0 >> 4; cx.sc0 = ch0 & 15; cx.sr1 = ch1 >> 4; cx.sc1 = ch1 & 15; }
  cx.kg = KDA + rowbase * DM + hd * 128; cx.vg = VDA + rowbase * DM + hd * 128;
  cx.koff = r * DA_KSTR + h * 16 + c * 128;
  cx.voff = 64 * DA_KSTR + (4 * h + ((lane & 15) >> 2)) * DA_KSTR + ((lane >> 4) & 1) * 32 + (lane & 3) * 8;
  cx.qpos = qpos; cx.h = h; cx.qs = qs; cx.q0 = q0;
#pragma unroll
  for (int t0 = 0; t0 < 2; ++t0) { const size_t ro = (size_t)t0 * 64; lds8* b = lds + t0 * DA_STAGE;
    const u32x4 kr0 = *(const u32x4*)(cx.kg + (ro + cx.sr0) * DM + cx.sc0 * 8), kr1 = *(const u32x4*)(cx.kg + (ro + cx.sr1) * DM + cx.sc1 * 8);
    const u32x4 vr0 = *(const u32x4*)(cx.vg + (ro + cx.sr0) * DM + cx.sc0 * 8), vr1 = *(const u32x4*)(cx.vg + (ro + cx.sr1) * DM + cx.sc1 * 8);
    *(LAS u32x4*)(b + cx.sr0 * DA_KSTR + cx.sc0 * 16) = kr0; *(LAS u32x4*)(b + cx.sr1 * DA_KSTR + cx.sc1 * 16) = kr1;
    *(LAS u32x4*)(b + 64 * DA_KSTR + cx.sr0 * DA_KSTR + cx.sc0 * 16) = vr0; *(LAS u32x4*)(b + 64 * DA_KSTR + cx.sr1 * DA_KSTR + cx.sc1 * 16) = vr1; }
  __syncthreads();
  f32x16 O[4];
#pragma unroll
  for (int d = 0; d < 4; ++d)
#pragma unroll
    for (int i = 0; i < 16; ++i) O[d][i] = 0.f;
  float muse = 0.f, l = 0.f;
  int t = 0;
  f32x16 negm;
#pragma unroll
  for (int i = 0; i < 16; ++i) negm[i] = 0.f;
  for (; t + 2 < nt; ++t) da_step<true, false>(lds, cx, t, q, O, muse, l, negm);
  da_step<false, true>(lds, cx, t, q, O, muse, l, negm); ++t;
  da_step<false, true>(lds, cx, t, q, O, muse, l, negm);
  __syncthreads();
  const float lt = l + __shfl_xor(l, 32); const float inv = 1.f / lt;
  LAS float* ex = (LAS float*)lds;
  if (c == 1) {
#pragma unroll
    for (int d = 0; d < 4; ++d)
#pragma unroll
      for (int i = 0; i < 16; ++i) ex[((qs * 4 + d) * 16 + i) * 64 + lane] = O[d][i] * inv;
  }
  __syncthreads();
  if (c == 0) {
    float ss = 0.f;
#pragma unroll
    for (int d = 0; d < 4; ++d)
#pragma unroll
      for (int i = 0; i < 16; ++i) { const float o = O[d][i] * inv - lam * ex[((qs * 4 + d) * 16 + i) * 64 + lane]; O[d][i] = o; ss += o * o; }
    ss += __shfl_xor(ss, 32);
    const float rn = rsqrtf(ss * (1.f / 128.f) + EPSN) * 0.8f;
    const float* gn = p.da_head_norm + hd * 128;
    bf16_t* yp = (bf16_t*)(ws + OFF_YDA) + (rowbase + qpos) * DM + hd * 128;
#pragma unroll
    for (int d = 0; d < 4; ++d)
#pragma unroll
      for (int ii = 0; ii < 4; ++ii) {
        const int dv = 32 * d + 8 * ii + 4 * h;
        const f32x4 g = *(const f32x4*)(gn + dv);
        u32x2 w; w.x = cvtpk(O[d][4 * ii] * rn * g[0], O[d][4 * ii + 1] * rn * g[1]); w.y = cvtpk(O[d][4 * ii + 2] * rn * g[2], O[d][4 * ii + 3] * rn * g[3]);
        *(u32x2*)(yp + dv) = w;
      }
  }
  __syncthreads();
}

constexpr int NS_STR = 144, NS_STAGE = 2 * 64 * NS_STR, NS_IMPW = 3 * NS_STAGE, NS_SCORE = NS_IMPW + 8 * 32 * 33 * 4, NS_MASK = NS_SCORE + 32 * 33 * 4, NS_UMASK = NS_MASK + 128, NS_LIST = NS_UMASK + 16;
struct CmpCap { float qs[2][8], ls[2][8], mrec[2]; };
template <int MODE, int SLOT> DI void ns_valu(volatile LAS int* jl, int t, int ntl, int qpos, int h, int blk, f32x16& s0, f32x16& s1, f32x16& du0, f32x16& du1, f32x16 (&O)[2], float& muse, float& l, bf16x8 (&P)[4], CmpCap& cap) {
    if (t < ntl) {
      const int j = __builtin_amdgcn_readfirstlane(jl[t]);
      if (MODE == 0) {
        const int lim = ((qpos - 31) >> 4) - 64 * j - 4 * h;
#pragma unroll
        for (int i = 0; i < 16; ++i) { const int ci = (i & 3) + 8 * (i >> 2); if (ci > lim) s0[i] = NEG; if (ci + 32 > lim) s1[i] = NEG; }
      } else if (MODE == 1) {
        if (j == blk) {
          const int lim = qpos - 64 * j - 4 * h;
#pragma unroll
          for (int i = 0; i < 16; ++i) { const int ci = (i & 3) + 8 * (i >> 2); if (ci > lim) s0[i] = NEG; if (ci + 32 > lim) s1[i] = NEG; }
        }
      } else {
        if (j == blk || j + 8 == blk) {
          const int lim = qpos - 64 * j - 4 * h, lo = lim - 512;
#pragma unroll
          for (int i = 0; i < 16; ++i) { const int ci = (i & 3) + 8 * (i >> 2); if (ci > lim || ci <= lo) s0[i] = NEG; if (ci + 32 > lim || ci + 32 <= lo) s1[i] = NEG; }
        }
      }
      softmax_def<2, false>(s0, s1, du0, du1, O, muse, l, t == 0, P);
      if (MODE == 0) {
#pragma unroll
        for (int ii = 0; ii < 4; ++ii) { cap.qs[SLOT][ii] = (s0[4 * ii] + s0[4 * ii + 1]) + (s0[4 * ii + 2] + s0[4 * ii + 3]); cap.ls[SLOT][ii] = s0[4 * ii + 3];
          cap.qs[SLOT][4 + ii] = (s1[4 * ii] + s1[4 * ii + 1]) + (s1[4 * ii + 2] + s1[4 * ii + 3]); cap.ls[SLOT][4 + ii] = s1[4 * ii + 3]; }
        cap.mrec[SLOT] = muse;
      }
    }
}
template <int MODE>
DI void nsa_branch(lds8* lds, const bf16_t* kg, const bf16_t* vg, int pitch, unsigned tiles, const bf16x8 (&q)[4], int qpos, unsigned mybits, int blk,
                   f32x16 (&O)[2], float& muse, float& l, int tid, int lane, int grp, CmpCap& cap) {
  const int r = lane & 31, h = lane >> 5;
  const int sr = tid >> 3, sc = tid & 7;
  const int koff = r * NS_STR + h * 16;
  const int voff = 64 * NS_STR + (4 * h + ((lane & 15) >> 2)) * NS_STR + ((lane >> 4) & 1) * 32 + (lane & 3) * 8;
  volatile LAS int* jl = (volatile LAS int*)(lds + NS_LIST);
  tiles = __builtin_amdgcn_readfirstlane(tiles);
  const int ntl = __builtin_popcount(tiles);
  if (tid < 32) { unsigned below = tiles & ((1u << tid) - 1u); if ((tiles >> tid) & 1u) jl[__builtin_popcount(below)] = tid; }
  __syncthreads();
#pragma unroll
  for (int d = 0; d < 2; ++d)
#pragma unroll
    for (int i = 0; i < 16; ++i) O[d][i] = 0.f;
  muse = 0.f; l = 0.f;
  u32x4 kra, vra;
#define NS_GLOAD(k_, KR, VR) do { const int jj = __builtin_amdgcn_readfirstlane(jl[(k_)]); KR = *(const u32x4*)(kg + (size_t)(64 * jj + sr) * pitch + sc * 8); VR = *(const u32x4*)(vg + (size_t)(64 * jj + sr) * pitch + sc * 8); } while (0)
#define NS_LSTORE(st_, KR, VR) do { lds8* b = lds + (st_) * NS_STAGE; *(LAS u32x4*)(b + sr * NS_STR + sc * 16) = KR; *(LAS u32x4*)(b + 64 * NS_STR + sr * NS_STR + sc * 16) = VR; } while (0)
  NS_GLOAD(0, kra, vra); NS_LSTORE(0, kra, vra);
  if (ntl > 1) { NS_GLOAD(1, kra, vra); NS_LSTORE(1, kra, vra); }
  __syncthreads();
  f32x16 s0, s1, du0, du1; bf16x8 P[4];
  int st_cur = 0;
#define NS_STEP(KR, VR, SLOT_) do { \
    if (t + 2 < ntl) NS_GLOAD(t + 2, KR, VR); \
    SBAR(); \
    { float bias = -muse; \
      if (MODE == 1) { const int jq = __builtin_amdgcn_readfirstlane(jl[t]); if (!((mybits >> jq) & 1u)) bias = NEG; } \
      qk64b<NS_STR>(s0, s1, lds + st_cur * NS_STAGE + koff, q, bias); } \
    ns_valu<MODE, SLOT_>(jl, t, ntl, qpos, h, blk, s0, s1, du0, du1, O, muse, l, P, cap); \
    pv64<NS_STR, 2>(O, lds + st_cur * NS_STAGE + voff, P); \
    if (t + 2 < ntl) NS_LSTORE((st_cur == 0) ? 2 : st_cur - 1, KR, VR); \
    st_cur = (st_cur == 2) ? 0 : st_cur + 1; \
    __syncthreads(); } while (0)
  for (int t = 0; t < ntl; ++t) {
    NS_STEP(kra, vra, 0);
    ++t; if (t >= ntl) break;
    NS_STEP(kra, vra, 1);
  }
#undef NS_STEP
#undef NS_GLOAD
#undef NS_LSTORE
}
DI void nsa_unit(const Params& p, lds8* lds, int bl, int g, int qb32) {
  int tid = threadIdx.x; asm volatile("" : "+v"(tid));
  const int lane = tid & 63, wid = __builtin_amdgcn_readfirstlane(tid >> 6);
  unsigned char* ws = p.ws;
  bf16_t* QNS = (bf16_t*)(ws + OFF_QNS); const bf16_t* KSW = (const bf16_t*)(ws + OFF_KSW); const bf16_t* VSW = (const bf16_t*)(ws + OFF_VSW);
  const bf16_t* KC = (const bf16_t*)(ws + OFF_KC); const bf16_t* VC = (const bf16_t*)(ws + OFF_VC); const bf16_t* GNS = (const bf16_t*)(ws + OFF_GNS);
  const float* rope = (const float*)(ws + OFF_ROPE);
  const int r = lane & 31, h = lane >> 5; const int hh = g * 8 + wid;
  const size_t rowbase = (size_t)bl * SEQ; const int q0 = qb32 * 32, qpos = q0 + r, blk = q0 >> 6;
  bf16x8 qraw[4], qrot[4];
  { const bf16_t* qp = QNS + (rowbase + qpos) * DM + hh * 64 + 8 * h;
#pragma unroll
    for (int ks = 0; ks < 4; ++ks) qraw[ks] = *(const bf16x8*)(qp + 16 * ks); }
  const bf16_t* gp = GNS + (rowbase + qpos) * 64 + hh * 3;
  const float g0 = bf2f(gp[0]), g1 = bf2f(gp[1]), g2 = bf2f(gp[2]);
  f32x16 OT[2], O[2]; float m, l; const int grp = ((wid >> 2) ^ wid) & 1;
  const bf16_t* kc = KC + (size_t)(bl * 2 + g) * 128 * 64; const bf16_t* vc = VC + (size_t)(bl * 2 + g) * 128 * 64;
  CmpCap cap;
  nsa_branch<0>(lds, kc, vc, 64, 3u, qraw, qpos, 0u, blk, O, m, l, tid, lane, grp, cap);
  const float lt0 = l + __shfl_xor(l, 32); const float inv0 = lt0 > 0.f ? 1.f / lt0 : 0.f;
  { const float f = g0 * inv0;
#pragma unroll
    for (int d = 0; d < 2; ++d)
#pragma unroll
      for (int i = 0; i < 16; ++i) OT[d][i] = O[d][i] * f; }
  { LAS float* impw = (LAS float*)(lds + NS_IMPW) + (wid * 32 + r) * 33;
    float carry = 0.f;
#pragma unroll
    for (int kt = 0; kt < 2; ++kt) {
      const float scale = __builtin_amdgcn_exp2f(cap.mrec[kt] - m) * inv0;
#pragma unroll
      for (int kb = 0; kb < 2; ++kb)
#pragma unroll
        for (int ii = 0; ii < 4; ++ii) {
          const float qsum = cap.qs[kt][kb * 4 + ii] * scale, last = cap.ls[kt][kb * 4 + ii] * scale;
          const float other = __shfl_xor(last, 32);
          const int ub = 16 * kt + 8 * kb + 2 * ii;
          const float val = qsum + (h ? other : carry);
          carry = other;
          impw[ub + h] = val;
        }
    }
  }
  __syncthreads();
#pragma unroll
  for (int ks = 0; ks < 2; ++ks) {
    const float* rc = rope + qpos * 32 + 16 * ks + 8 * h;
    const f32x4 c0 = *(const f32x4*)rc, c1 = *(const f32x4*)(rc + 4), s0 = *(const f32x4*)(rc + 65536), s1 = *(const f32x4*)(rc + 65536 + 4);
    float o1[8], o2[8];
#pragma unroll
    for (int e = 0; e < 8; ++e) { const float x1 = bf2f((unsigned short)qraw[ks][e]), x2 = bf2f((unsigned short)qraw[ks + 2][e]); const float cc = e < 4 ? c0[e & 3] : c1[e & 3], sn = e < 4 ? s0[e & 3] : s1[e & 3];
      o1[e] = x1 * cc - x2 * sn; o2[e] = x2 * cc + x1 * sn; }
    u32x4 w; w.x = cvtpk(o1[0], o1[1]); w.y = cvtpk(o1[2], o1[3]); w.z = cvtpk(o1[4], o1[5]); w.w = cvtpk(o1[6], o1[7]); qrot[ks] = __builtin_bit_cast(bf16x8, w);
    w.x = cvtpk(o2[0], o2[1]); w.y = cvtpk(o2[2], o2[3]); w.z = cvtpk(o2[4], o2[5]); w.w = cvtpk(o2[6], o2[7]); qrot[ks + 2] = __builtin_bit_cast(bf16x8, w);
  }
  LAS float* score = (LAS float*)(lds + NS_SCORE); LAS unsigned* maskl = (LAS unsigned*)(lds + NS_MASK); LAS unsigned* umaskl = (LAS unsigned*)(lds + NS_UMASK);
  if (tid == 0) *umaskl = 0u;
  { const LAS float* iw = (const LAS float*)(lds + NS_IMPW);
    for (int idx = tid; idx < 32 * 32; idx += 512) { const int qq = idx >> 5, s = idx & 31; float a = 0.f;
#pragma unroll
      for (int w = 0; w < 8; ++w) a += iw[(w * 32 + qq) * 33 + s];
      if (s == 0 || s == blk || s == blk - 1) a = 1e9f;
      score[qq * 33 + s] = a; } }
  __syncthreads();
  { const int qq = tid >> 4, sb2 = (tid & 15) * 2; unsigned bits = 0u;
#pragma unroll
    for (int e = 0; e < 2; ++e) { const int s = sb2 + e;
      if (s <= blk) { const float v = score[qq * 33 + s]; int rank = 0;
        for (int s2 = 0; s2 <= blk; ++s2) { const float v2 = score[qq * 33 + s2]; rank += (v2 > v || (v2 == v && s2 < s)) ? 1 : 0; }
        if (rank < 16) bits |= 1u << s; } }
    bits |= __shfl_xor(bits, 1); bits |= __shfl_xor(bits, 2); bits |= __shfl_xor(bits, 4); bits |= __shfl_xor(bits, 8);
    if ((tid & 15) == 0) { maskl[qq] = bits; atomicOr((unsigned*)umaskl, bits); } }
  __syncthreads();
  const unsigned mybits = maskl[r]; const unsigned umask = *umaskl;
  nsa_branch<1>(lds, KSW + rowbase * 256 + g * 64, VSW + rowbase * 256 + g * 64, 256, umask, qrot, qpos, mybits, blk, O, m, l, tid, lane, grp, cap);
  { const float lt = l + __shfl_xor(l, 32); const float f = g1 / lt;
#pragma unroll
    for (int d = 0; d < 2; ++d)
#pragma unroll
      for (int i = 0; i < 16; ++i) OT[d][i] += O[d][i] * f; }
  { const int jlo = blk >= 8 ? blk - 8 : 0; const unsigned wt = (blk == 31 ? 0xffffffffu : ((1u << (blk + 1)) - 1u)) & ~((1u << jlo) - 1u);
    nsa_branch<2>(lds, KSW + rowbase * 256 + 128 + g * 64, VSW + rowbase * 256 + 128 + g * 64, 256, wt, qrot, qpos, 0u, blk, O, m, l, tid, lane, grp, cap); }
  { const float lt = l + __shfl_xor(l, 32); const float f = g2 / lt;
#pragma unroll
    for (int d = 0; d < 2; ++d)
#pragma unroll
      for (int i = 0; i < 16; ++i) OT[d][i] += O[d][i] * f; }
  bf16_t* yp = (bf16_t*)(ws + OFF_YNS) + (rowbase + qpos) * DM + hh * 64;
#pragma unroll
  for (int d = 0; d < 2; ++d)
#pragma unroll
    for (int ii = 0; ii < 4; ++ii) {
      const int dv = 32 * d + 8 * ii + 4 * h;
      u32x2 w; w.x = cvtpk(OT[d][4 * ii], OT[d][4 * ii + 1]); w.y = cvtpk(OT[d][4 * ii + 2], OT[d][4 * ii + 3]);
      *(u32x2*)(yp + dv) = w;
    }
}

#ifndef PH_FFN
#define PH_FFN 1
#endif
#ifndef PH_WIN
#define PH_WIN 1
#endif
#ifndef PH_CMP
#define PH_CMP 1
#endif
#ifndef PH_DA
#define PH_DA 1
#endif
#ifndef PH_NSA
#define PH_NSA 1
#endif
#ifndef PH_MRG1
#define PH_MRG1 1
#endif
#ifndef PH_OUT
#define PH_OUT 1
#endif
#ifndef REP_PRO
#define REP_PRO 1
#endif
#ifndef REP_SYNC
#define REP_SYNC 0
#endif
#ifndef REP_CMP
#define REP_CMP 1
#endif
#ifndef REP_UP
#define REP_UP 1
#endif
#ifndef REP_DA
#define REP_DA 1
#endif
#ifndef REP_NSA
#define REP_NSA 1
#endif
#ifndef PH_MRG
#define PH_MRG 1
#endif

#define XB_TMO      128
#define XB_XCNT(j)  (256  + 64 * (j))
#define XB_XSUB(j)  (1280 + 64 * (j))
#define XB_XGEN(j)  (2304 + 64 * (j))
#define XB_TOP      3328
#define XB_TOPGEN   3392
#define XCD_BAR_WORDS 3456
#define XB_SPIN_CAP (1u << 18)

__device__ __forceinline__ unsigned xb_ld(unsigned* p)              { return __hip_atomic_load(p, __ATOMIC_RELAXED, __HIP_MEMORY_SCOPE_AGENT); }
__device__ __forceinline__ unsigned xb_add(unsigned* p, unsigned v) { return __hip_atomic_fetch_add(p, v, __ATOMIC_RELAXED, __HIP_MEMORY_SCOPE_AGENT); }
__device__ __forceinline__ unsigned xb_xcc_id() { return (unsigned)__builtin_amdgcn_s_getreg((3 << 11) | 20) & 0xFu; }
#define XB_SPIN(cond, bar) do { unsigned _sp = 0; while (cond) { __builtin_amdgcn_s_sleep(1); \
    if ((++_sp & 255u) == 0u) { if (xb_ld(&(bar)[XB_TMO])) break; if (_sp > XB_SPIN_CAP) { atomicAdd(&(bar)[XB_TMO], 1u); break; } } } } while (0)

struct XcdBarrier {
    unsigned* bar; unsigned x;
    volatile LAS unsigned* st;
};

__device__ __forceinline__ XcdBarrier xcd_barrier_post(unsigned* bar, volatile LAS unsigned* st) {
    XcdBarrier b; b.bar = bar; b.x = xb_xcc_id(); b.st = st;
    if (threadIdx.x == 0) (void)xb_add(&bar[XB_XCNT(b.x)], 1u);
    return b;
}
__device__ __forceinline__ void xcd_barrier_complete(unsigned* bar, unsigned x, unsigned& nloc, unsigned& nx) {
    const unsigned G = gridDim.x * gridDim.y * gridDim.z;
    unsigned sum, cnt, mine, sp = 0u;
    for (;;) {
        sum = 0u; cnt = 0u; mine = 0u;
#pragma unroll
        for (unsigned j = 0; j < 16; ++j) { const unsigned c = xb_ld(&bar[XB_XCNT(j)]); sum += c; cnt += (c > 0u) ? 1u : 0u; mine = (j == x) ? c : mine; }
        if (sum == G) break;
        __builtin_amdgcn_s_sleep(1);
        if ((++sp & 255u) == 0u) { if (xb_ld(&bar[XB_TMO])) break; if (sp > XB_SPIN_CAP) { atomicAdd(&bar[XB_TMO], 1u); break; } }
    }
    nloc = mine > 0u ? mine : 1u; nx = cnt > 0u ? cnt : 1u;
}

__device__ __forceinline__ void xcd_barrier(const XcdBarrier& b) {
    asm volatile("s_waitcnt vmcnt(0)" ::: "memory");
    __syncthreads();
    if (threadIdx.x == 0) {
        unsigned* bar = b.bar;
        __builtin_amdgcn_s_waitcnt(0);
        unsigned nloc = b.st[0], nx = b.st[1];
        if (nloc == 0u) { xcd_barrier_complete(bar, b.x, nloc, nx); b.st[0] = nloc; b.st[1] = nx; }
        const unsigned old = xb_add(&bar[XB_XSUB(b.x)], 1u);
        const unsigned gen = old / nloc;
        if (old + 1u == (gen + 1u) * nloc) {
            __builtin_amdgcn_fence(__ATOMIC_RELEASE, "agent");
            asm volatile("s_waitcnt vmcnt(0)" ::: "memory");
            const unsigned og = xb_add(&bar[XB_TOP], 1u);
            const unsigned tg = og / nx;
            if (og + 1u == (tg + 1u) * nx) xb_add(&bar[XB_TOPGEN], 1u);
            else XB_SPIN(xb_ld(&bar[XB_TOPGEN]) == tg, bar);
            __builtin_amdgcn_fence(__ATOMIC_ACQUIRE, "agent");
            xb_add(&bar[XB_XGEN(b.x)], 1u);
            asm volatile("s_waitcnt vmcnt(0)" ::: "memory");
        } else {
            XB_SPIN(xb_ld(&bar[XB_XGEN(b.x)]) == gen, bar);
            __builtin_amdgcn_fence(__ATOMIC_ACQUIRE, "agent");
            asm volatile("s_waitcnt vmcnt(0)" ::: "memory");
        }
    }
    __syncthreads();
}

DI void ablk_prep_block(const Params& p, int pm) {
  int tid = threadIdx.x; asm volatile("" : "+v"(tid));
  const bf16_t* KVC = (const bf16_t*)(p.ws + OFF_KVC); bf16_t* AB = (bf16_t*)(p.ws + OFF_ABLK);
  const int kv = pm >> 4, bl = pm & 15;
  for (int idx = tid; idx < 256 * 256; idx += 512) {
    const int ch = idx & 255, rl = idx >> 8;
    const int g = rl & 1, n = rl >> 1; const int l = ch >> 3, d0 = (ch & 7) * 8;
    u32x4 o = {0u, 0u, 0u, 0u};
    if (n < 127) {
      const u32x4 v = *(const u32x4*)(KVC + ((size_t)bl * SEQ + 16 * n + l) * 256 + kv * 128 + g * 64 + d0);
      const float* ps = p.cmp_pos + (kv * 32 + l) * 64 + d0; const f32x4 p0 = *(const f32x4*)ps, p1 = *(const f32x4*)(ps + 4);
      o.x = cvtpk(bflo(v.x) + p0[0], bfhi(v.x) + p0[1]); o.y = cvtpk(bflo(v.y) + p0[2], bfhi(v.y) + p0[3]);
      o.z = cvtpk(bflo(v.z) + p1[0], bfhi(v.z) + p1[1]); o.w = cvtpk(bflo(v.w) + p1[2], bfhi(v.w) + p1[3]);
    }
    *(u32x4*)(AB + ((size_t)pm * 256 + rl) * 2048 + ch * 8) = o;
  }
}
DI void cmp_gemm2_block(const Params& p, lds8* lds, int pm) {
  int tid = threadIdx.x; asm volatile("" : "+v"(tid));
  const int kv = pm >> 4, bl = pm & 15;
  LAS float* wl = (LAS float*)lds;
  const float* w2 = p.cmp_w2 + (size_t)kv * 256 * 64;
  for (int i = tid; i < 256 * 64 / 4; i += 512) *(LAS f32x4*)(wl + i * 4) = *(const f32x4*)(w2 + i * 4);
  __syncthreads();
  const int rl = tid >> 1, dh = (tid & 1) * 32;
  const bf16_t* hr = (const bf16_t*)(p.ws + OFF_HID) + ((size_t)pm * 256 + rl) * 256;
  float a[32];
#pragma unroll
  for (int e = 0; e < 32; ++e) a[e] = 0.f;
#pragma unroll 1
  for (int j = 0; j < 256; j += 2) {
    const unsigned hv = *(const unsigned*)(hr + j);
    const float h0 = bflo(hv), h1 = bfhi(hv);
    const LAS float* w0 = wl + j * 64 + dh;
#pragma unroll
    for (int e4 = 0; e4 < 8; ++e4) { const f32x4 wa = *(const LAS f32x4*)(w0 + 4 * e4), wb = *(const LAS f32x4*)(w0 + 64 + 4 * e4);
      a[4 * e4] += h0 * wa[0] + h1 * wb[0]; a[4 * e4 + 1] += h0 * wa[1] + h1 * wb[1]; a[4 * e4 + 2] += h0 * wa[2] + h1 * wb[2]; a[4 * e4 + 3] += h0 * wa[3] + h1 * wb[3]; }
  }
  const int g = rl & 1, n = rl >> 1;
  bf16_t* dst = (bf16_t*)(p.ws + (kv ? OFF_VC : OFF_KC)) + ((size_t)(bl * 2 + g) * 128 + n) * 64 + dh;
#pragma unroll
  for (int e8 = 0; e8 < 4; ++e8) { u32x4 w; w.x = cvtpk(a[8 * e8], a[8 * e8 + 1]); w.y = cvtpk(a[8 * e8 + 2], a[8 * e8 + 3]); w.z = cvtpk(a[8 * e8 + 4], a[8 * e8 + 5]); w.w = cvtpk(a[8 * e8 + 6], a[8 * e8 + 7]);
    *(u32x4*)(dst + 8 * e8) = w; }
  __syncthreads();
}
#define BLOCK_SEAM() do { asm volatile("s_waitcnt vmcnt(0)" ::: "memory"); __syncthreads(); __builtin_amdgcn_fence(__ATOMIC_ACQUIRE, "agent"); asm volatile("s_waitcnt vmcnt(0)" ::: "memory"); } while (0)

__global__ void __launch_bounds__(512, 2) fwd_mega(Params p) {
  extern __shared__ __attribute__((aligned(16))) unsigned char lds_raw[];
  lds8* lds = (lds8*)lds_raw;
  cg::grid_group grid = cg::this_grid();
  const int G = gridDim.x, bid = blockIdx.x;
  const int NGW = G * 8, nthr = G * 512;
  unsigned char* ws = p.ws;
  float* ssq = (float*)(ws + OFF_SSQ);
  bf16_t* XB = (bf16_t*)(ws + OFF_XB); bf16_t* H = (bf16_t*)(ws + OFF_BIG);
  using pg8::Gemm; using pg8::StaticOrder;
  volatile LAS unsigned* bst = (volatile LAS unsigned*)(lds + 131072 + 256);
  if (threadIdx.x < 2) bst[threadIdx.x] = 0u;
  __syncthreads();
  (void)xcd_barrier_post((unsigned*)(ws + OFF_BAR), bst);
#define GSYNC() do { XcdBarrier b_; b_.bar = (unsigned*)(p.ws + OFF_BAR); b_.x = xb_xcc_id(); b_.st = (volatile LAS unsigned*)(lds + 131072 + 256); xcd_barrier(b_); } while (0)

  for (int rep = 0; rep < REP_PRO; ++rep) prologue(p, lds, NGW);
  if (p.ws == nullptr) grid.sync();
  GSYNC();
  for (int rep = 0; rep < REP_SYNC; ++rep) GSYNC();
#if PH_FFN
  for (int rep = 0; rep < REP_UP; ++rep)
  { Gemm g{XB, (const bf16_t*)(ws + OFF_W13_1), MTOK, 2 * DFF, DM}; StaticOrder S; S.init(MTOK, 2 * DFF, G, bid); EpiSwiGLU E{H, ssq};
    pg8::gemm_phase<EpiSwiGLU, StaticOrder, true, true>(lds, g, S, E); }
  GSYNC();
  { Gemm g{H, (const bf16_t*)(ws + OFF_W2_1), MTOK, DM, DFF}; StaticOrder S; S.init(MTOK, DM, G, bid); EpiResid E{XB, XB, ssq + MTOK, 0.5f, 0};
    pg8::gemm_phase<EpiResid, StaticOrder, true, true>(lds, g, S, E); }
  GSYNC();
#endif
  float lam;
  { float a = 0.f, b = 0.f;
    for (int i = 0; i < 64; ++i) { a += p.da_lambda[i] * p.da_lambda[64 + i]; b += p.da_lambda[128 + i] * p.da_lambda[192 + i]; }
    lam = __uint_as_float(__builtin_amdgcn_readfirstlane(__float_as_uint(__expf(a) - __expf(b) + 0.2f))); }
  for (int ck = 0; ck < NCHUNK; ++ck) {
    const int row_off = ck * MC;
#if PH_WIN
    { Gemm g{XB + (size_t)row_off * DM, (const bf16_t*)(ws + OFF_WIN), MC, NIN, DM}; StaticOrder S; S.init(MC, NIN, G, bid);
      EpiWin E{ssq + MTOK, row_off, (const float*)(ws + OFF_ROPE), (bf16_t*)(ws + OFF_QDA), (bf16_t*)(ws + OFF_KDA), (bf16_t*)(ws + OFF_VDA), (bf16_t*)(ws + OFF_QNS),
               (bf16_t*)(ws + OFF_KVC), (bf16_t*)(ws + OFF_KSW), (bf16_t*)(ws + OFF_VSW), (bf16_t*)(ws + OFF_GNS), (bf16_t*)(ws + OFF_GA), (bf16_t*)(ws + OFF_GB)};
      pg8::gemm_phase<EpiWin, StaticOrder, true, true>(lds, g, S, E); }
#endif
    GSYNC();
    volatile LAS unsigned* wq = (volatile LAS unsigned*)(lds + 131072 + 512);
    unsigned* qcnt = (unsigned*)(ws + OFF_BAR + 14336) + ck * 128;
    unsigned* cflag = (unsigned*)(ws + OFF_BAR + 15360) + ck * 64;
#if PH_CMP
    if (bid < 32) {
      for (int rep = 0; rep < REP_CMP; ++rep) {
      ablk_prep_block(p, bid);
      BLOCK_SEAM();
      { Gemm g{(const bf16_t*)(ws + OFF_ABLK), (const bf16_t*)(ws + OFF_W1C), 8192, 512, 2048}; CmpOrder S{bid}; EpiGelu E{(bf16_t*)(ws + OFF_HID)};
        pg8::gemm_phase<EpiGelu, CmpOrder, true, true>(lds, g, S, E); }
      BLOCK_SEAM();
      cmp_gemm2_block(p, lds, bid);
      }
      asm volatile("s_waitcnt vmcnt(0)" ::: "memory");
      __syncthreads();
      if (threadIdx.x == 0) { __builtin_amdgcn_fence(__ATOMIC_RELEASE, "agent"); asm volatile("s_waitcnt vmcnt(0)" ::: "memory");
        __hip_atomic_fetch_add(cflag, 1u, __ATOMIC_RELAXED, __HIP_MEMORY_SCOPE_AGENT); }
    }
#endif
#if PH_DA
    for (int rep = 0; rep < REP_DA; ++rep) {
      if (threadIdx.x == 0) *wq = atomicAdd(qcnt + 64 * rep, 1u);
      __syncthreads();
      int u = (int)*wq;
      __syncthreads();
      while (u < 2048) {
        unsigned nxt = 0u;
        if (threadIdx.x == 0) nxt = atomicAdd(qcnt + 64 * rep, 1u);
        const int qb = 15 - (u >> 7), bh = u & 127; da_unit(p, lds, bh >> 3, bh & 7, qb, lam);
        if (threadIdx.x == 0) *wq = nxt;
        __syncthreads();
        u = (int)*wq;
        __syncthreads();
      }
    }
#endif
    if (threadIdx.x == 0) { while (__hip_atomic_load(cflag, __ATOMIC_RELAXED, __HIP_MEMORY_SCOPE_AGENT) < 32u) __builtin_amdgcn_s_sleep(4);
      __builtin_amdgcn_fence(__ATOMIC_ACQUIRE, "agent"); asm volatile("s_waitcnt vmcnt(0)" ::: "memory"); }
    __syncthreads();
#if PH_NSA
    for (int rep = 0; rep < REP_NSA; ++rep) {
      if (threadIdx.x == 0) *wq = atomicAdd(qcnt + 32 + 64 * rep, 1u);
      __syncthreads();
      int u = (int)*wq;
      __syncthreads();
      while (u < 2048) {
        unsigned nxt = 0u;
        if (threadIdx.x == 0) nxt = atomicAdd(qcnt + 32 + 64 * rep, 1u);
        const int qb32 = 63 - (u >> 5), bg = u & 31; nsa_unit(p, lds, bg >> 1, bg & 1, qb32);
        if (threadIdx.x == 0) *wq = nxt;
        __syncthreads();
        u = (int)*wq;
        __syncthreads();
      }
    }
#endif
    GSYNC();
#if PH_MRG
    { Gemm g{(const bf16_t*)(ws + OFF_YDA), (const bf16_t*)(ws + OFF_WPD), MC, DM, DM}; StaticOrder S; S.init(MC, DM, G, bid); EpiMerge<0> E{(const bf16_t*)(ws + OFF_GA), (bf16_t*)(ws + OFF_MRG)};
      pg8::gemm_phase<EpiMerge<0>, StaticOrder, true, true>(lds, g, S, E); }
#if PH_MRG1
    { Gemm g{(const bf16_t*)(ws + OFF_YNS), (const bf16_t*)(ws + OFF_WPN), MC, DM, DM}; StaticOrder S; S.init(MC, DM, G, bid); EpiMerge<1> E{(const bf16_t*)(ws + OFF_GB), (bf16_t*)(ws + OFF_MRG)};
      pg8::gemm_phase<EpiMerge<1>, StaticOrder, true, true>(lds, g, S, E); }
#endif
    GSYNC();
#if PH_OUT
    { Gemm g{(const bf16_t*)(ws + OFF_MRG), (const bf16_t*)(ws + OFF_WOUT), MC, DM, DM}; StaticOrder S; S.init(MC, DM, G, bid); EpiResid E{XB, XB, ssq + 2 * MTOK, 1.0f, row_off};
      pg8::gemm_phase<EpiResid, StaticOrder, true, true>(lds, g, S, E); }
#endif
#endif
    if (ck == NCHUNK - 1) GSYNC();
  }
#if PH_FFN
  { Gemm g{XB, (const bf16_t*)(ws + OFF_W13_2), MTOK, 2 * DFF, DM}; StaticOrder S; S.init(MTOK, 2 * DFF, G, bid); EpiSwiGLU E{H, ssq + 2 * MTOK};
    pg8::gemm_phase<EpiSwiGLU, StaticOrder, true, true>(lds, g, S, E); }
  GSYNC();
  { Gemm g{H, (const bf16_t*)(ws + OFF_W2_2), MTOK, DM, DFF}; StaticOrder S; S.init(MTOK, DM, G, bid); EpiResid E{XB, XB, ssq + 3 * MTOK, 0.5f, 0};
    pg8::gemm_phase<EpiResid, StaticOrder, true, true>(lds, g, S, E); }
#endif
  GSYNC();
  { int tidf = threadIdx.x; asm volatile("" : "+v"(tidf)); const int lane = tidf & 63; const int gw = bid * 8 + (tidf >> 6);
    for (int m = gw; m < MTOK; m += 2 * NGW) {
      const int m2 = (m + NGW < MTOK) ? m + NGW : m;
      const float q1 = ssq[3 * MTOK + m], q2 = ssq[3 * MTOK + m2];
      const u32x4* xr = (const u32x4*)(XB + (size_t)m * DM) + lane; const u32x4* xr2 = (const u32x4*)(XB + (size_t)m2 * DM) + lane;
      const u32x4 va0 = xr[0], va1 = xr[64], vb0 = xr2[0], vb1 = xr2[64];
      const f32x4* gr = (const f32x4*)p.final_norm;
#pragma unroll
      for (int rr = 0; rr < 2; ++rr) {
        if (rr == 1 && m2 == m) break;
        const float rstd = rsqrtf((rr ? q2 : q1) * (1.f / DM) + EPSN);
        f32x4* orow = (f32x4*)(p.out + (size_t)(rr ? m2 : m) * DM);
#pragma unroll
        for (int j = 0; j < 2; ++j) { const u32x4 v = rr ? (j ? vb1 : vb0) : (j ? va1 : va0); const int c4 = (64 * j + lane) * 2;
          const f32x4 g0 = gr[c4], g1 = gr[c4 + 1];
          f32x4 o0, o1; o0[0] = bflo(v.x) * rstd * g0[0]; o0[1] = bfhi(v.x) * rstd * g0[1]; o0[2] = bflo(v.y) * rstd * g0[2]; o0[3] = bfhi(v.y) * rstd * g0[3];
          o1[0] = bflo(v.z) * rstd * g1[0]; o1[1] = bfhi(v.z) * rstd * g1[1]; o1[2] = bflo(v.w) * rstd * g1[2]; o1[3] = bfhi(v.w) * rstd * g1[3];
          __builtin_nontemporal_store(o0, &orow[c4]); __builtin_nontemporal_store(o1, &orow[c4 + 1]); }
      }
    } }
}

extern "C" void kernel_launch(void* const* d_in, const int* in_sizes, int n_in, void* d_out, int out_size, void* d_ws, size_t ws_size, hipStream_t stream) {
  constexpr int LDSB = 147456;
  static int grid_blocks = 0;
  if (!grid_blocks) {
    if (n_in != 20 || ws_size < WS_END || ws_size < OFF_BIG + (size_t)MTOK * DFF * 2) { fprintf(stderr, "kernel_launch: unexpected inputs / workspace (%d inputs, %zu bytes)\n", n_in, ws_size); grid_blocks = -1; return; }
    int dev = 0, cus = 0, per_cu = 0;
    (void)hipGetDevice(&dev);
    (void)hipDeviceGetAttribute(&cus, hipDeviceAttributeMultiprocessorCount, dev);
    (void)hipFuncSetAttribute((const void*)fwd_mega, hipFuncAttributeMaxDynamicSharedMemorySize, LDSB);
    (void)hipOccupancyMaxActiveBlocksPerMultiprocessor(&per_cu, (const void*)fwd_mega, 512, LDSB);
    if (per_cu < 1) per_cu = 1;
    grid_blocks = cus * per_cu;
  }
  if (grid_blocks < 0) return;
  Params p{};
  const float** pp = (const float**)&p;
  for (int i = 0; i < 20; ++i) pp[i] = (const float*)d_in[i];
  p.out = (float*)d_out; p.ws = (unsigned char*)d_ws;
  (void)hipMemsetAsync((unsigned char*)d_ws + OFF_BAR, 0, 16384, stream);
  void* args[] = {&p};
  hipError_t e = hipLaunchCooperativeKernel((void*)fwd_mega, dim3(grid_blocks), dim3(512), args, LDSB, stream);
  if (e != hipSuccess) fprintf(stderr, "cooperative launch failed: %s (grid %d)\n", hipGetErrorString(e), grid_blocks);
}
```

```cpp
#include <hip/hip_runtime.h>
#include <hip/hip_cooperative_groups.h>
#include <cstdio>
#include <cstdint>
namespace cg = cooperative_groups;
namespace pg8 {
#define PG8_LAS __attribute__((address_space(3)))
typedef unsigned short bf16_t;
typedef short bf16x8 __attribute__((ext_vector_type(8)));
typedef float f32x4 __attribute__((ext_vector_type(4)));
typedef unsigned u32x4 __attribute__((ext_vector_type(4)));
constexpr int BM = 256, BK = 64, HALF = 128, HTB = HALF * BK * 2  , STAGE_BYTES = 8 * HTB, NXCD = 8, WGM = 8;

__host__ __device__ __forceinline__ int lds_byte(int r, int c) { const int st = (r >> 4) * 2 + (c >> 5), rr = r & 15, cc = c & 31, ob = rr * 64 + cc * 2; return st * 1024 + (ob ^ (((ob >> 9) & 1) << 5)); }
__host__ __device__ __forceinline__ void stage_rc(int b, int& R, int& C) { const int st = b / 1024, sb = b % 1024, swz = sb ^ (((sb >> 9) & 1) << 5); R = (st >> 1) * 16 + swz / 64; C = (st & 1) * 32 + (swz % 64) / 2; }
__host__ __device__ __forceinline__ int perm32(int rho) { const int n = rho >> 4, i = rho & 15; return 8 * (i >> 2) + 4 * n + (i & 3); }

struct Unit { int pm, pn; };
struct Gemm { const bf16_t* A; const bf16_t* Bt; int M, N, K; };

struct StaticOrder {
    int nM, nN, nwg, G, c;
    __host__ __device__ void init(int M, int N, int G_, int c_) { nM = M / BM; nN = N / BM; nwg = nM * nN; G = G_; c = c_; }
    __host__ __device__ bool next(int i, Unit& u) const {
        const long L = (long)i * G + c; if (L >= nwg) return false;
        int wgid = (int)L; { const int q = nwg / NXCD, r = nwg % NXCD, xcd = wgid % NXCD, off = wgid / NXCD; wgid = (xcd < r ? xcd * (q + 1) : r * (q + 1) + (xcd - r) * q) + off; }
        const int nig = WGM * nN, gid = wgid / nig, fm = gid * WGM, gsz = (nM - fm) < WGM ? (nM - fm) : WGM;
        u.pm = fm + ((wgid % nig) % gsz); u.pn = (wgid % nig) / gsz; return true;
    }
    __device__ __forceinline__ void a_ready(const Unit&) const {}
    __device__ __forceinline__ void done(const Unit&) const {}
};

__device__ __forceinline__ unsigned cvt_pk_bf16(float lo, float hi) { unsigned r; asm volatile("v_cvt_pk_bf16_f32 %0, %1, %2" : "=v"(r) : "v"(lo), "v"(hi)); return r; }
template <class Epi, class Sched, bool ALIGN_EPI = false, bool SP2 = false>
__device__ __forceinline__ void gemm_phase(PG8_LAS unsigned char* lds, const Gemm g, const Sched& S, const Epi& E) {
    int tid_ = threadIdx.x; asm volatile("" : "+v"(tid_));
    const int tid = tid_, wid = __builtin_amdgcn_readfirstlane(tid >> 6), lane = tid & 63, wr = wid >> 2, wc = wid & 3, fr = lane & 15, fq = lane >> 4;
    const int K = g.K, nt = K / BK;
    unsigned voffA[2], voffB[2];
#pragma unroll
    for (int i = 0; i < 2; ++i) { int R, C; stage_rc(tid * 16 + i * 8192, R, C); const int Rb = Epi::PERM ? ((R & ~31) + perm32(R & 31)) : R;
        voffA[i] = (unsigned)(R * K + C) * 2u; voffB[i] = (unsigned)(Rb * K + C) * 2u; }
    const size_t kstep = (size_t)(BK * 2);
    const size_t hstep = (size_t)HALF * K * 2;
    const size_t tstep = 2 * hstep;
    const unsigned ldsw = (unsigned)wid * 1024u;
    const int aoff = lds_byte(wr * 64 + fr, fq * 8), boff = lds_byte(wc * 32 + fr, fq * 8);
#define PG8_SA(b, h) (((b) * 2 + (h)) * HTB)
#define PG8_SB(b, h) ((4 + (b) * 2 + (h)) * HTB)
#define PG8_STAGE(bufoff, gbase, voff) do { _Pragma("unroll") for (int _i = 0; _i < 2; ++_i) \
        __builtin_amdgcn_global_load_lds((const unsigned*)((const char*)(gbase) + (voff)[_i]), (PG8_LAS unsigned*)(lds + (bufoff) + ldsw + _i * 8192), 16, 0, 0); } while (0)
#define PG8_LDA(dst, b, h) do { _Pragma("unroll") for (int m = 0; m < 4; ++m) _Pragma("unroll") for (int k = 0; k < 2; ++k) dst[m][k] = *(const PG8_LAS bf16x8*)(lds + PG8_SA(b, h) + aoff + m * 2048 + k * 1024); } while (0)
#define PG8_LDB(dst, b, h) do { _Pragma("unroll") for (int n = 0; n < 2; ++n) _Pragma("unroll") for (int k = 0; k < 2; ++k) dst[n][k] = *(const PG8_LAS bf16x8*)(lds + PG8_SB(b, h) + boff + n * 2048 + k * 1024); } while (0)
#define PG8_MMA(ai, bj, At, Bt) do { __builtin_amdgcn_s_setprio(1); _Pragma("unroll") for (int m = 0; m < 4; ++m) _Pragma("unroll") for (int n = 0; n < 2; ++n) _Pragma("unroll") for (int k = 0; k < 2; ++k) \
        acc[ai][bj][m][n] = __builtin_amdgcn_mfma_f32_16x16x32_bf16(Bt[n][k], At[m][k], acc[ai][bj][m][n], 0, 0, 0); __builtin_amdgcn_s_setprio(0); } while (0)
#define PG8_WAIT_V(n) asm volatile("s_waitcnt vmcnt(" #n ")" ::: "memory")
#define PG8_WAIT_L(n) asm volatile("s_waitcnt lgkmcnt(" #n ")" ::: "memory")
#define PG8_BAR __builtin_amdgcn_s_barrier()
#define PG8_SCHED __builtin_amdgcn_sched_barrier(0)
    Unit cur, nxt; int ui = 0;
    if (!S.next(0, cur)) return;
    f32x4 acc[2][2][4][2];
#pragma unroll
    for (int a = 0; a < 2; ++a)
#pragma unroll
        for (int b = 0; b < 2; ++b)
#pragma unroll
            for (int m = 0; m < 4; ++m)
#pragma unroll
                for (int n = 0; n < 2; ++n) acc[a][b][m][n] = (f32x4){0.f, 0.f, 0.f, 0.f};
    bf16x8 At[4][2], B0[2][2], B1[2][2];
    const char* cA = (const char*)g.A + (size_t)cur.pm * tstep; const char* cB = (const char*)g.Bt + (size_t)cur.pn * tstep;
    S.a_ready(cur);
    if constexpr (SP2) {
        PG8_STAGE(PG8_SB(0, 0), cB, voffB); PG8_STAGE(PG8_SB(0, 1), cB + hstep, voffB); PG8_STAGE(PG8_SA(0, 0), cA, voffA); PG8_STAGE(PG8_SA(0, 1), cA + hstep, voffA);
        if (wr == 1) PG8_BAR;
        PG8_WAIT_V(2); PG8_BAR;
        PG8_STAGE(PG8_SB(1, 0), cB + kstep, voffB); PG8_STAGE(PG8_SA(1, 0), cA + kstep, voffA); PG8_STAGE(PG8_SB(1, 1), cB + hstep + kstep, voffB);
        PG8_WAIT_V(6); PG8_BAR;
    } else {
        PG8_STAGE(PG8_SB(0, 0), cB, voffB); PG8_STAGE(PG8_SA(0, 0), cA, voffA); PG8_STAGE(PG8_SB(0, 1), cB + hstep, voffB); PG8_STAGE(PG8_SA(0, 1), cA + hstep, voffA);
        if (wr == 1) PG8_BAR;
        PG8_WAIT_V(4); PG8_BAR;
        PG8_STAGE(PG8_SB(1, 0), cB + kstep, voffB); PG8_STAGE(PG8_SA(1, 0), cA + kstep, voffA); PG8_STAGE(PG8_SB(1, 1), cB + hstep + kstep, voffB);
        PG8_WAIT_V(6); PG8_BAR;
    }
    for (;;) {
        const bool has_next = S.next(ui + 1, nxt);
        const char* nA = has_next ? (const char*)g.A + (size_t)nxt.pm * tstep : cA; const char* nB = has_next ? (const char*)g.Bt + (size_t)nxt.pn * tstep : cB;
        for (int t = 0; t < nt; t += 2) {
            const bool last = (t == nt - 2);
            const char* a1 = cA + (size_t)(t + 1) * kstep;
            const char* a2 = last ? nA : cA + (size_t)(t + 2) * kstep; const char* b2 = last ? nB : cB + (size_t)(t + 2) * kstep;
            const char* a3 = a2 + kstep; const char* b3 = b2 + kstep;
            if (last && has_next) S.a_ready(nxt);
            if constexpr (SP2) {
            PG8_LDB(B0, 0, 0); PG8_LDB(B1, 0, 1); PG8_SCHED; PG8_LDA(At, 0, 0); PG8_STAGE(PG8_SA(1, 1), a1 + hstep, voffA);
            PG8_WAIT_V(8); PG8_WAIT_L(0); PG8_BAR; PG8_MMA(0, 0, At, B0); PG8_MMA(0, 1, At, B1); PG8_BAR; PG8_SCHED;
            PG8_LDA(At, 0, 1); PG8_STAGE(PG8_SB(0, 0), b2, voffB); PG8_STAGE(PG8_SB(0, 1), b2 + hstep, voffB); PG8_STAGE(PG8_SA(0, 0), a2, voffA);
            PG8_WAIT_V(8); PG8_WAIT_L(0); PG8_BAR; PG8_MMA(1, 0, At, B0); PG8_MMA(1, 1, At, B1); PG8_BAR; PG8_SCHED;
            PG8_LDB(B0, 1, 0); PG8_LDB(B1, 1, 1); PG8_SCHED; PG8_LDA(At, 1, 0); PG8_STAGE(PG8_SA(0, 1), a2 + hstep, voffA);
            PG8_WAIT_V(8); PG8_WAIT_L(0); PG8_BAR; PG8_MMA(0, 0, At, B0); PG8_MMA(0, 1, At, B1); PG8_BAR; PG8_SCHED;
            PG8_LDA(At, 1, 1); PG8_STAGE(PG8_SB(1, 0), b3, voffB); PG8_STAGE(PG8_SB(1, 1), b3 + hstep, voffB); PG8_STAGE(PG8_SA(1, 0), a3, voffA);
            PG8_WAIT_V(8); PG8_WAIT_L(0); PG8_BAR; PG8_MMA(1, 0, At, B0); PG8_MMA(1, 1, At, B1); PG8_BAR; PG8_SCHED;
            } else {
            PG8_LDB(B0, 0, 0); PG8_SCHED; PG8_LDA(At, 0, 0); PG8_STAGE(PG8_SA(1, 1), a1 + hstep, voffA);
            PG8_WAIT_L(8); PG8_BAR; PG8_WAIT_L(0); PG8_MMA(0, 0, At, B0); PG8_BAR; PG8_SCHED;
            PG8_LDB(B1, 0, 1); PG8_STAGE(PG8_SB(0, 0), b2, voffB);
            PG8_BAR; PG8_WAIT_L(0); PG8_MMA(0, 1, At, B1); PG8_BAR;
            PG8_LDA(At, 0, 1); PG8_STAGE(PG8_SA(0, 0), a2, voffA);
            PG8_BAR; PG8_WAIT_L(0); PG8_MMA(1, 0, At, B0); PG8_BAR; PG8_SCHED;
            PG8_STAGE(PG8_SB(0, 1), b2 + hstep, voffB);
            PG8_WAIT_V(6); PG8_BAR; PG8_MMA(1, 1, At, B1); PG8_BAR;
            PG8_LDB(B0, 1, 0); PG8_SCHED; PG8_LDA(At, 1, 0); PG8_STAGE(PG8_SA(0, 1), a2 + hstep, voffA);
            PG8_WAIT_L(8); PG8_BAR; PG8_WAIT_L(0); PG8_MMA(0, 0, At, B0); PG8_BAR; PG8_SCHED;
            PG8_LDB(B1, 1, 1); PG8_STAGE(PG8_SB(1, 0), b3, voffB);
            PG8_BAR; PG8_WAIT_L(0); PG8_MMA(0, 1, At, B1); PG8_BAR;
            PG8_LDA(At, 1, 1); PG8_STAGE(PG8_SA(1, 0), a3, voffA);
            PG8_BAR; PG8_WAIT_L(0); PG8_MMA(1, 0, At, B0); PG8_BAR; PG8_SCHED;
            PG8_STAGE(PG8_SB(1, 1), b3 + hstep, voffB);
            PG8_WAIT_V(6); PG8_BAR; PG8_MMA(1, 1, At, B1); PG8_BAR;
            }
        }
        if constexpr (ALIGN_EPI) { if (wr == 0) PG8_BAR; }
        if constexpr (!Epi::AFTER_DRAIN) { E(acc, cur, wr, wc, fr, fq); S.done(cur); }
        if (!has_next) break;
#pragma unroll
        for (int a = 0; a < 2; ++a)
#pragma unroll
            for (int b = 0; b < 2; ++b)
#pragma unroll
                for (int m = 0; m < 4; ++m)
#pragma unroll
                    for (int n = 0; n < 2; ++n) acc[a][b][m][n] = (f32x4){0.f, 0.f, 0.f, 0.f};
        cur = nxt; cA = nA; cB = nB; ++ui;
        if constexpr (ALIGN_EPI) { if (wr == 1) PG8_BAR; }
    }
    PG8_WAIT_V(0);
    if constexpr (!ALIGN_EPI) { if (wr == 0) PG8_BAR; }
    PG8_BAR;
    if constexpr (Epi::AFTER_DRAIN) { E.fused(acc, cur, wr, wc, fr, fq, lds, wid, lane); S.done(cur); }
#undef PG8_SA
#undef PG8_SB
#undef PG8_STAGE
#undef PG8_LDA
#undef PG8_LDB
#undef PG8_MMA
#undef PG8_WAIT_V
#undef PG8_WAIT_L
#undef PG8_BAR
#undef PG8_SCHED
}
}

#define LAS __attribute__((address_space(3)))
typedef LAS unsigned char lds8;
typedef unsigned short bf16_t;
typedef short bf16x8 __attribute__((ext_vector_type(8)));
typedef short s16x4 __attribute__((ext_vector_type(4)));
typedef float f32x4 __attribute__((ext_vector_type(4)));
typedef float f32x16 __attribute__((ext_vector_type(16)));
typedef unsigned u32x4 __attribute__((ext_vector_type(4)));
typedef unsigned u32x2 __attribute__((ext_vector_type(2)));
typedef float f32x2_t __attribute__((ext_vector_type(2)));
typedef __bf16 bf16x2_t __attribute__((ext_vector_type(2)));

constexpr int DM = 1024, BATCH = 32, SEQ = 2048, MTOK = BATCH * SEQ, DFF = 2816;
constexpr int NCHUNK = 2, CB = BATCH / NCHUNK, MC = CB * SEQ;
constexpr int NIN = 7168;
constexpr float EPSN = 1e-6f;
constexpr float QSCALE = 0.125f * 1.4426950408889634f;
constexpr float NEG = -1e30f;
constexpr size_t MiB = 1u << 20;
constexpr size_t OFF_SSQ = 0;
constexpr size_t OFF_ROPE = 1 * MiB, OFF_BAR = 1 * MiB + 512 * 1024;
constexpr size_t OFF_W13_1 = 2 * MiB, OFF_W2_1 = 14 * MiB, OFF_W13_2 = 20 * MiB, OFF_W2_2 = 32 * MiB, OFF_WIN = 38 * MiB;
constexpr size_t OFF_WPD = 52 * MiB, OFF_WPN = 54 * MiB, OFF_WOUT = 56 * MiB, OFF_W1C = 58 * MiB;
constexpr size_t OFF_XB = 64 * MiB;
constexpr size_t OFF_BIG = 192 * MiB;
constexpr size_t OFF_QDA = OFF_BIG, OFF_KDA = OFF_QDA + 64 * MiB, OFF_VDA = OFF_KDA + 64 * MiB, OFF_QNS = OFF_VDA + 64 * MiB;
constexpr size_t OFF_GA = OFF_QNS + 64 * MiB, OFF_GB = OFF_GA + 64 * MiB, OFF_MRG = OFF_GB + 64 * MiB;
constexpr size_t OFF_KVC = OFF_MRG + 64 * MiB, OFF_KSW = OFF_KVC + 16 * MiB, OFF_VSW = OFF_KSW + 16 * MiB, OFF_GNS = OFF_VSW + 16 * MiB;
constexpr size_t OFF_ABLK = OFF_GNS + 4 * MiB, OFF_HID = OFF_ABLK + 32 * MiB, OFF_KC = OFF_HID + 4 * MiB, OFF_VC = OFF_KC + 1 * MiB;
constexpr size_t OFF_YDA = OFF_VC + 1 * MiB, OFF_YNS = OFF_YDA + 64 * MiB;
constexpr size_t WS_END = OFF_YNS + 64 * MiB;
static_assert(OFF_BIG + (size_t)MTOK * DFF * 2 <= 1024 * MiB && WS_END <= 1024 * MiB, "ws map");

__constant__ float c_invfreq[32] = {1.000000000e+00f, 7.498942018e-01f, 5.623413324e-01f, 4.216965139e-01f, 3.162277639e-01f, 2.371373922e-01f, 1.778279394e-01f, 1.333521456e-01f, 1.000000015e-01f, 7.498941571e-02f, 5.623412877e-02f, 4.216964915e-02f, 3.162277862e-02f, 2.371373586e-02f, 1.778279431e-02f, 1.333521493e-02f, 9.999999776e-03f, 7.498942316e-03f, 5.623413250e-03f, 4.216964822e-03f, 3.162277862e-03f, 2.371373819e-03f, 1.778279431e-03f, 1.333521446e-03f, 1.000000047e-03f, 7.498941850e-04f, 5.623413017e-04f, 4.216965463e-04f, 3.162277862e-04f, 2.371373848e-04f, 1.778279402e-04f, 1.333521504e-04f};

#define DI __device__ __forceinline__
DI unsigned cvtpk(float lo, float hi) { f32x2_t v = {lo, hi}; bf16x2_t b = __builtin_convertvector(v, bf16x2_t); return __builtin_bit_cast(unsigned, b); }
DI float bf2f(unsigned short u) { return __uint_as_float(((unsigned)u) << 16); }
DI float bflo(unsigned w) { return __uint_as_float(w << 16); }
DI float bfhi(unsigned w) { return __uint_as_float(w & 0xffff0000u); }
DI float sigmoidf_(float v) { return __builtin_amdgcn_rcpf(1.f + __builtin_amdgcn_exp2f(-v * 1.4426950408889634f)); }
DI u32x4 pack8(f32x4 a, f32x4 b) { u32x4 w; w.x = cvtpk(a[0], a[1]); w.y = cvtpk(a[2], a[3]); w.z = cvtpk(b[0], b[1]); w.w = cvtpk(b[2], b[3]); return w; }
DI int crow(int i, int h) { return (i & 3) + 8 * (i >> 2) + 4 * h; }
#define MFMA32(a, b, c) __builtin_amdgcn_mfma_f32_32x32x16_bf16((a), (b), (c), 0, 0, 0)

struct Params {
  const float *x, *ffn1_norm, *ffn1_w1, *ffn1_w3, *ffn1_w2, *mix_norm, *w_in, *da_lambda, *da_head_norm, *cmp_pos, *cmp_w1, *cmp_w2,
      *w_proj_da, *w_proj_nsa, *w_out, *ffn2_norm, *ffn2_w1, *ffn2_w3, *ffn2_w2, *final_norm;
  float* out; unsigned char* ws;
};

using pg8::Unit;
struct EpiSwiGLU {
  static constexpr bool PERM = true, AFTER_DRAIN = false;
  bf16_t* H; const float* ssq;
  DI void operator()(const f32x4 (&acc)[2][2][4][2], const Unit& u, int wr, int wc, int fr, int fq) const {
    const int row0 = u.pm * 256 + wr * 64 + fr; const int hcol = u.pn * 128 + wc * 32 + 8 * fq;
    float rs[8];
#pragma unroll
    for (int i = 0; i < 8; ++i) rs[i] = ssq[row0 + (i >> 2) * 128 + (i & 3) * 16];
#pragma unroll
    for (int ai = 0; ai < 2; ++ai)
#pragma unroll
      for (int m = 0; m < 4; ++m) {
        const int row = row0 + ai * 128 + m * 16;
        const float rstd = rsqrtf(rs[ai * 4 + m] * (1.f / DM) + EPSN);
        f32x4 o[2];
#pragma unroll
        for (int n = 0; n < 2; ++n) {
          const f32x4 a = acc[ai][0][m][n] * rstd, b = acc[ai][1][m][n] * rstd;
#pragma unroll
          for (int e = 0; e < 4; ++e) o[n][e] = a[e] * sigmoidf_(a[e]) * b[e];
        }
        __builtin_nontemporal_store(pack8(o[0], o[1]), (u32x4*)(H + (size_t)row * DFF + hcol));
      }
  }
};
struct EpiResid {
  static constexpr bool PERM = true, AFTER_DRAIN = false;
  const bf16_t* xin_b; bf16_t* xb; float* ssq_out; float scale; int row_off;
  DI void operator()(const f32x4 (&acc)[2][2][4][2], const Unit& u, int wr, int wc, int fr, int fq) const {
    const int row0 = row_off + u.pm * 256 + wr * 64 + fr; const int col0 = u.pn * 256 + wc * 32 + 8 * fq;
#pragma unroll
    for (int ai = 0; ai < 2; ++ai) {
      u32x4 xv[4][2];
#pragma unroll
      for (int m = 0; m < 4; ++m)
#pragma unroll
        for (int bj = 0; bj < 2; ++bj) xv[m][bj] = *(const u32x4*)(xin_b + (size_t)(row0 + ai * 128 + m * 16) * DM + col0 + bj * 128);
      asm volatile("" ::: "memory");
#pragma unroll
      for (int m = 0; m < 4; ++m) {
        const int row = row0 + ai * 128 + m * 16; float s = 0.f;
#pragma unroll
        for (int bj = 0; bj < 2; ++bj) {
          const size_t off = (size_t)row * DM + col0 + bj * 128;
          const u32x4 v = xv[m][bj];
          const f32x4 x0 = {bflo(v.x), bfhi(v.x), bflo(v.y), bfhi(v.y)}, x1 = {bflo(v.z), bfhi(v.z), bflo(v.w), bfhi(v.w)};
          const f32x4 y0 = x0 + acc[ai][bj][m][0] * scale, y1 = x1 + acc[ai][bj][m][1] * scale;
          *(u32x4*)(xb + off) = pack8(y0, y1);
          s += (y0[0] * y0[0] + y0[1] * y0[1]) + (y0[2] * y0[2] + y0[3] * y0[3]) + (y1[0] * y1[0] + y1[1] * y1[1]) + (y1[2] * y1[2] + y1[3] * y1[3]);
        }
        s += __shfl_xor(s, 16); s += __shfl_xor(s, 32);
        if (fq == 0) atomicAdd(ssq_out + row, s);
      }
      asm volatile("" ::: "memory");
    }
  }
};
struct EpiWin {
  static constexpr bool PERM = true, AFTER_DRAIN = false;
  const float* ssq; int row_off; const float* rope;
  bf16_t *QDA, *KDA, *VDA, *QNS, *KVC, *KSW, *VSW, *GNS, *GA, *GB;
  DI void operator()(const f32x4 (&acc)[2][2][4][2], const Unit& u, int wr, int wc, int fr, int fq) const {
    const int tl = u.pn; const int rowl0 = u.pm * 256 + wr * 64 + fr; const int c8 = wc * 32 + 8 * fq;
    if (tl < 8 || tl == 17) {
      bf16_t* dst; int colbase, pitch; float sc = 1.f;
      if (tl < 4) { dst = QDA; colbase = (tl * 4 + wc) * 64; pitch = DM; sc = QSCALE; }
      else if (tl < 8) { dst = KDA; colbase = ((tl - 4) * 4 + wc) * 64; pitch = DM; }
      else { dst = KSW; colbase = wc * 64; pitch = 256; }
#pragma unroll
      for (int ai = 0; ai < 2; ++ai)
#pragma unroll
        for (int m = 0; m < 4; ++m) {
          const int rowl = rowl0 + ai * 128 + m * 16; const int t = rowl & (SEQ - 1);
          const float rstd = rsqrtf(ssq[row_off + rowl] * (1.f / DM) + EPSN) * sc;
          const float* rc = rope + t * 32 + 8 * fq;
          const f32x4 c0 = *(const f32x4*)(rc), c1 = *(const f32x4*)(rc + 4), s0 = *(const f32x4*)(rc + 65536), s1 = *(const f32x4*)(rc + 65536 + 4);
          const f32x4 x1a = acc[ai][0][m][0] * rstd, x1b = acc[ai][0][m][1] * rstd, x2a = acc[ai][1][m][0] * rstd, x2b = acc[ai][1][m][1] * rstd;
          const f32x4 o1a = x1a * c0 - x2a * s0, o1b = x1b * c1 - x2b * s1, o2a = x2a * c0 + x1a * s0, o2b = x2b * c1 + x1b * s1;
          bf16_t* d = dst + (size_t)rowl * pitch + colbase + 8 * fq;
          *(u32x4*)(d) = pack8(o1a, o1b); *(u32x4*)(d + 32) = pack8(o2a, o2b);
          asm volatile("" ::: "memory");
        }
    } else {
      bf16_t* dst; int coloff = 0, pitch = DM, mode = 0;
      if (tl < 12) { dst = VDA; coloff = (tl - 8) * 256; }
      else if (tl < 16) { dst = QNS; coloff = (tl - 12) * 256; mode = 1; }
      else if (tl == 16) { dst = KVC; pitch = 256; }
      else if (tl == 18) { dst = VSW; pitch = 256; }
      else if (tl == 19) { dst = GNS; pitch = 64; mode = 2; }
      else if (tl < 24) { dst = GA; coloff = (tl - 20) * 256; mode = 2; }
      else { dst = GB; coloff = (tl - 24) * 256; mode = 2; }
#pragma unroll
      for (int ai = 0; ai < 2; ++ai)
#pragma unroll
        for (int m = 0; m < 4; ++m) {
          const int rowl = rowl0 + ai * 128 + m * 16;
          const float rstd = rsqrtf(ssq[row_off + rowl] * (1.f / DM) + EPSN) * (mode == 1 ? QSCALE : 1.f);
#pragma unroll
          for (int bj = 0; bj < 2; ++bj) {
            const int col = bj * 128 + c8;
            if (tl == 19 && col >= 64) continue;
            f32x4 v0 = acc[ai][bj][m][0] * rstd, v1 = acc[ai][bj][m][1] * rstd;
            if (mode == 2) {
#pragma unroll
              for (int e = 0; e < 4; ++e) { v0[e] = sigmoidf_(v0[e]); v1[e] = sigmoidf_(v1[e]); }
            }
            if (tl >= 20) __builtin_nontemporal_store(pack8(v0, v1), (u32x4*)(dst + (size_t)rowl * pitch + coloff + col));
            else *(u32x4*)(dst + (size_t)rowl * pitch + coloff + col) = pack8(v0, v1);
          }
        }
    }
  }
};
struct EpiGelu {
  static constexpr bool PERM = true, AFTER_DRAIN = false;
  bf16_t* HID;
  DI void operator()(const f32x4 (&acc)[2][2][4][2], const Unit& u, int wr, int wc, int fr, int fq) const {
    const int row0 = u.pm * 256 + wr * 64 + fr; const int c8 = wc * 32 + 8 * fq;
#pragma unroll
    for (int ai = 0; ai < 2; ++ai)
#pragma unroll
      for (int m = 0; m < 4; ++m)
#pragma unroll
        for (int bj = 0; bj < 2; ++bj) {
          f32x4 v[2];
#pragma unroll
          for (int n = 0; n < 2; ++n)
#pragma unroll
            for (int e = 0; e < 4; ++e) { const float a = acc[ai][bj][m][n][e]; const float z = 0.7978845608028654f * (a + 0.044715f * a * a * a); v[n][e] = a * sigmoidf_(2.f * z); }
          *(u32x4*)(HID + (size_t)(row0 + ai * 128 + m * 16) * 256 + bj * 128 + c8) = pack8(v[0], v[1]);
          asm volatile("" ::: "memory");
        }
  }
};
template <int STEP> struct EpiMerge {
  static constexpr bool PERM = true, AFTER_DRAIN = false;
  const bf16_t* gate; bf16_t* MRG;
  DI void operator()(const f32x4 (&acc)[2][2][4][2], const Unit& u, int wr, int wc, int fr, int fq) const {
    const int row0 = u.pm * 256 + wr * 64 + fr; const int col0 = u.pn * 256 + wc * 32 + 8 * fq;
#pragma unroll
    for (int ai = 0; ai < 2; ++ai) {
      u32x4 gv[4][2];
#pragma unroll
      for (int m = 0; m < 4; ++m)
#pragma unroll
        for (int bj = 0; bj < 2; ++bj) gv[m][bj] = *(const u32x4*)(gate + (size_t)(row0 + ai * 128 + m * 16) * DM + col0 + bj * 128);
#pragma unroll
      for (int mb = 0; mb < 4; mb += 2) {
        u32x4 pv[2][2];
        if (STEP == 1) {
#pragma unroll
          for (int mm = 0; mm < 2; ++mm)
#pragma unroll
            for (int bj = 0; bj < 2; ++bj) pv[mm][bj] = *(const u32x4*)(MRG + (size_t)(row0 + ai * 128 + (mb + mm) * 16) * DM + col0 + bj * 128);
        }
        asm volatile("" ::: "memory");
#pragma unroll
        for (int mm = 0; mm < 2; ++mm)
#pragma unroll
          for (int bj = 0; bj < 2; ++bj) {
            const int m = mb + mm;
            const size_t off = (size_t)(row0 + ai * 128 + m * 16) * DM + col0 + bj * 128;
            const u32x4 g = gv[m][bj];
            f32x4 v0 = acc[ai][bj][m][0], v1 = acc[ai][bj][m][1];
            v0[0] *= bflo(g.x); v0[1] *= bfhi(g.x); v0[2] *= bflo(g.y); v0[3] *= bfhi(g.y); v1[0] *= bflo(g.z); v1[1] *= bfhi(g.z); v1[2] *= bflo(g.w); v1[3] *= bfhi(g.w);
            if (STEP == 1) { const u32x4 p = pv[mm][bj];
              v0[0] += bflo(p.x); v0[1] += bfhi(p.x); v0[2] += bflo(p.y); v0[3] += bfhi(p.y); v1[0] += bflo(p.z); v1[1] += bfhi(p.z); v1[2] += bflo(p.w); v1[3] += bfhi(p.w); }
            *(u32x4*)(MRG + off) = pack8(v0, v1);
          }
        asm volatile("" ::: "memory");
      }
    }
  }
};
struct PanelOrder {
  int G, c;
  DI bool next(int i, Unit& u) const { const int pm = c + (i >> 2) * G; if (pm >= MTOK / 256) return false; u.pm = pm; u.pn = i & 3; return true; }
  DI void a_ready(const Unit&) const {}
  DI void done(const Unit&) const {}
};
struct CmpOrder {
  int c;
  DI bool next(int i, Unit& u) const { if (i > 0 || c >= 32) return false; u.pm = c; u.pn = c >> 4; return true; }
  DI void a_ready(const Unit&) const {}
  DI void done(const Unit&) const {}
};

DI void conv_item(const float* W, int ldw, int srccol0, const float* gain, int K, bf16_t* WT, int n0, int k0, LAS float* scr, int lane) {
  float vv[32];
#pragma unroll
  for (int i = 0; i < 32; ++i) { const int kk = 2 * i + (lane >> 5); vv[i] = W ? W[(size_t)(k0 + kk) * ldw + srccol0 + (lane & 31)] : 0.f; }
  if (gain) {
#pragma unroll
    for (int i = 0; i < 32; ++i) vv[i] *= gain[k0 + 2 * i + (lane >> 5)];
  }
#pragma unroll
  for (int i = 0; i < 32; ++i) scr[(2 * i + (lane >> 5)) * 33 + (lane & 31)] = vv[i];
  asm volatile("s_waitcnt lgkmcnt(0)" ::: "memory");
  const int c = lane & 7;
#pragma unroll
  for (int j = 0; j < 4; ++j) { const int n = (lane >> 3) + 8 * j; const LAS float* s = scr + (8 * c) * 33 + n;
    u32x4 o; o.x = cvtpk(s[0 * 33], s[1 * 33]); o.y = cvtpk(s[2 * 33], s[3 * 33]); o.z = cvtpk(s[4 * 33], s[5 * 33]); o.w = cvtpk(s[6 * 33], s[7 * 33]);
    *(u32x4*)(WT + (size_t)(n0 + n) * K + k0 + 8 * c) = o; }
  asm volatile("s_waitcnt lgkmcnt(0)" ::: "memory");
}
DI int win_src(int n0) {
  const int tl = n0 >> 8, j = n0 & 255;
  if (tl < 8 || (tl >= 12 && tl < 16)) {
    if (tl >= 12) return 3072 + (tl - 12) * 256 + j;
    const int base = (tl < 4) ? 0 : 1024; const int lt = tl & 3;
    return base + lt * 256 + ((j & 127) >> 5) * 64 + (j >> 7) * 32;
  }
  if (tl < 12) return 2048 + (tl - 8) * 256 + j;
  if (tl == 16) return 4096 + j;
  if (tl == 17) { const int hm = (j & 127) >> 5; const int b = (hm < 2) ? 4352 + hm * 64 : 4608 + (hm - 2) * 64; return b + (j >> 7) * 32; }
  if (tl == 18) return (j < 128) ? 4480 + j : 4736 + (j - 128);
  if (tl == 19) return (j < 64) ? 4864 + j : -1;
  if (tl < 24) return 4912 + (tl - 20) * 256 + j;
  return 5936 + (tl - 24) * 256 + j;
}
DI void prologue(const Params& p, lds8* lds, int NGW) {
  int tid = threadIdx.x; asm volatile("" : "+v"(tid));
  const int lane = tid & 63, wid = __builtin_amdgcn_readfirstlane(tid >> 6); const int gw = blockIdx.x * 8 + wid;
  unsigned char* ws = p.ws;
  LAS float* scr = (LAS float*)(lds + wid * 8704);
  constexpr int I13 = 16 * 176, I2 = 44 * 32, IWIN = 16 * 224, IP = 16 * 32, IC = 32 * 8;
  constexpr int NITEMS = 2 * I13 + 2 * I2 + IWIN + 3 * IP + 2 * IC;
  for (int it = gw; it < NITEMS; it += NGW) {
    int r = it;
    if (r < 2 * I13) { const int f = r / I13; r -= f * I13; const int kb = r / 176, nb = r % 176, n0 = nb * 32; const int tp = n0 >> 8, j = n0 & 255;
      const float* W = f ? (j < 128 ? p.ffn2_w1 : p.ffn2_w3) : (j < 128 ? p.ffn1_w1 : p.ffn1_w3);
      conv_item(W, DFF, tp * 128 + (j & 127), f ? p.ffn2_norm : p.ffn1_norm, DM, (bf16_t*)(ws + (f ? OFF_W13_2 : OFF_W13_1)), n0, kb * 64, scr, lane); continue; }
    r -= 2 * I13;
    if (r < 2 * I2) { const int f = r / I2; r -= f * I2; const int kb = r / 32, nb = r % 32;
      conv_item(f ? p.ffn2_w2 : p.ffn1_w2, DM, nb * 32, nullptr, DFF, (bf16_t*)(ws + (f ? OFF_W2_2 : OFF_W2_1)), nb * 32, kb * 64, scr, lane); continue; }
    r -= 2 * I2;
    if (r < IWIN) { const int kb = r / 224, nb = r % 224; const int sc = win_src(nb * 32);
      conv_item(sc >= 0 ? p.w_in : nullptr, 6960, sc, p.mix_norm, DM, (bf16_t*)(ws + OFF_WIN), nb * 32, kb * 64, scr, lane); continue; }
    r -= IWIN;
    if (r < 3 * IP) { const int f = r / IP; r -= f * IP; const int kb = r / 32, nb = r % 32;
      conv_item(f == 0 ? p.w_proj_da : (f == 1 ? p.w_proj_nsa : p.w_out), DM, nb * 32, nullptr, DM, (bf16_t*)(ws + (f == 0 ? OFF_WPD : (f == 1 ? OFF_WPN : OFF_WOUT))), nb * 32, kb * 64, scr, lane); continue; }
    r -= 3 * IP;
    { const int f = r / IC; r -= f * IC; const int kb = r / 8, nb = r % 8;
      conv_item(p.cmp_w1 + (size_t)f * 2048 * 256, 256, nb * 32, nullptr, 2048, (bf16_t*)(ws + OFF_W1C) + (size_t)f * 256 * 2048, nb * 32, kb * 64, scr, lane); }
  }
  float* ssq = (float*)(ws + OFF_SSQ); bf16_t* XB = (bf16_t*)(ws + OFF_XB);
  for (int m = gw; m < MTOK; m += 2 * NGW) {
    const int m2 = m + NGW; const bool has2 = m2 < MTOK;
    const f32x4* xr = (const f32x4*)(p.x + (size_t)m * DM) + lane; const f32x4* xr2 = (const f32x4*)(p.x + (size_t)(has2 ? m2 : m) * DM) + lane;
    f32x4 v[4], w[4];
#pragma unroll
    for (int j = 0; j < 4; ++j) { v[j] = __builtin_nontemporal_load(&xr[64 * j]); w[j] = __builtin_nontemporal_load(&xr2[64 * j]); }
    float s = 0.f, s2 = 0.f;
    u32x2* o8 = (u32x2*)(XB + (size_t)m * DM) + lane; u32x2* o82 = (u32x2*)(XB + (size_t)m2 * DM) + lane;
#pragma unroll
    for (int j = 0; j < 4; ++j) { s += (v[j][0] * v[j][0] + v[j][1] * v[j][1]) + (v[j][2] * v[j][2] + v[j][3] * v[j][3]); u32x2 o; o.x = cvtpk(v[j][0], v[j][1]); o.y = cvtpk(v[j][2], v[j][3]); o8[64 * j] = o;
      s2 += (w[j][0] * w[j][0] + w[j][1] * w[j][1]) + (w[j][2] * w[j][2] + w[j][3] * w[j][3]); if (has2) { u32x2 o2; o2.x = cvtpk(w[j][0], w[j][1]); o2.y = cvtpk(w[j][2], w[j][3]); o82[64 * j] = o2; } }
#pragma unroll
    for (int o = 1; o < 64; o <<= 1) { s += __shfl_xor(s, o); s2 += __shfl_xor(s2, o); }
    if (lane == 0) { ssq[m] = s; ssq[MTOK + m] = 0.f; ssq[2 * MTOK + m] = 0.f; ssq[3 * MTOK + m] = 0.f;
      if (has2) { ssq[m2] = s2; ssq[MTOK + m2] = 0.f; ssq[2 * MTOK + m2] = 0.f; ssq[3 * MTOK + m2] = 0.f; } }
  }
  float* rope = (float*)(ws + OFF_ROPE);
  for (int idx = gw * 64 + lane; idx < SEQ * 32; idx += NGW * 64) {
    const int t = idx >> 5, i = idx & 31;
    const float ang = (float)t * c_invfreq[i];
    const double ad = (double)ang; const double k = rint(ad * 0.15915494309189535); const float rr = (float)(ad - k * 6.283185307179586);
    rope[idx] = __cosf(rr); rope[65536 + idx] = __sinf(rr);
  }
}

#define SBAR() __builtin_amdgcn_sched_barrier(0)
template <int KSTR> DI void qk64(f32x16& s0, f32x16& s1, const lds8* kp, const bf16x8 (&q)[4]) {
  bf16x8 a[8];
#pragma unroll
  for (int ks = 0; ks < 4; ++ks) { a[2 * ks] = *(const LAS bf16x8*)(kp + ks * 32); a[2 * ks + 1] = *(const LAS bf16x8*)(kp + 32 * KSTR + ks * 32); }
#pragma unroll
  for (int i = 0; i < 16; ++i) { s0[i] = 0.f; s1[i] = 0.f; }
  SBAR();
  __builtin_amdgcn_s_setprio(1);
#pragma unroll
  for (int ks = 0; ks < 4; ++ks) { s0 = MFMA32(a[2 * ks], q[ks], s0); s1 = MFMA32(a[2 * ks + 1], q[ks], s1); }
  __builtin_amdgcn_s_setprio(0);
  SBAR();
}
DI s16x4 trrd(const lds8* p) { typedef short v4i16_t __attribute__((ext_vector_type(4))); return __builtin_bit_cast(s16x4, __builtin_amdgcn_ds_read_tr16_b64_v4i16((LAS v4i16_t*)p)); }
template <int VSTR, int NDVB> DI void pv64(f32x16 (&O)[NDVB], const lds8* vp, const bf16x8 (&P)[4]) {
  bf16x8 f[2][NDVB];
#pragma unroll
  for (int d = 0; d < NDVB; ++d) { const s16x4 lo = trrd(vp + d * 64), hi = trrd(vp + 8 * VSTR + d * 64); f[0][d] = __builtin_shufflevector(lo, hi, 0, 1, 2, 3, 4, 5, 6, 7); }
#pragma unroll
  for (int kk = 0; kk < 4; ++kk) {
    if (kk < 3) {
#pragma unroll
      for (int d = 0; d < NDVB; ++d) { const s16x4 lo = trrd(vp + (16 * (kk + 1)) * VSTR + d * 64), hi = trrd(vp + (16 * (kk + 1) + 8) * VSTR + d * 64);
        f[(kk + 1) & 1][d] = __builtin_shufflevector(lo, hi, 0, 1, 2, 3, 4, 5, 6, 7); }
    }
    SBAR();
    __builtin_amdgcn_s_setprio(1);
#pragma unroll
    for (int d = 0; d < NDVB; ++d) O[d] = MFMA32(f[kk & 1][d], P[kk], O[d]);
    __builtin_amdgcn_s_setprio(0);
    SBAR();
  }
}
DI float softmax_step(f32x16& s0, f32x16& s1, float& m, float& l, bf16x8 (&P)[4]) {
  float mx = fmaxf(s0[0], s1[0]);
#pragma unroll
  for (int i = 1; i < 16; ++i) mx = fmaxf(mx, fmaxf(s0[i], s1[i]));
  mx = fmaxf(mx, __shfl_xor(mx, 32));
  const float mnew = fmaxf(m, mx); const float muse = (mnew < -1e29f) ? 0.f : mnew;
  const float alpha = __builtin_amdgcn_exp2f(m - muse);
  m = mnew; float sum = 0.f;
#pragma unroll
  for (int i = 0; i < 16; ++i) { s0[i] = __builtin_amdgcn_exp2f(s0[i] - muse); s1[i] = __builtin_amdgcn_exp2f(s1[i] - muse); sum += s0[i] + s1[i]; }
  l = l * alpha + sum;
  u32x4 w;
  w.x = cvtpk(s0[0], s0[1]); w.y = cvtpk(s0[2], s0[3]); w.z = cvtpk(s0[4], s0[5]); w.w = cvtpk(s0[6], s0[7]); P[0] = __builtin_bit_cast(bf16x8, w);
  w.x = cvtpk(s0[8], s0[9]); w.y = cvtpk(s0[10], s0[11]); w.z = cvtpk(s0[12], s0[13]); w.w = cvtpk(s0[14], s0[15]); P[1] = __builtin_bit_cast(bf16x8, w);
  w.x = cvtpk(s1[0], s1[1]); w.y = cvtpk(s1[2], s1[3]); w.z = cvtpk(s1[4], s1[5]); w.w = cvtpk(s1[6], s1[7]); P[2] = __builtin_bit_cast(bf16x8, w);
  w.x = cvtpk(s1[8], s1[9]); w.y = cvtpk(s1[10], s1[11]); w.z = cvtpk(s1[12], s1[13]); w.w = cvtpk(s1[14], s1[15]); P[3] = __builtin_bit_cast(bf16x8, w);
  return alpha;
}

constexpr int DA_KSTR = 304, DA_STAGE = 2 * 64 * DA_KSTR;
template <int KSTR> DI void qk64b(f32x16& s0, f32x16& s1, const lds8* kp, const bf16x8 (&q)[4], float bias) {
  bf16x8 a[8];
#pragma unroll
  for (int ks = 0; ks < 4; ++ks) { a[2 * ks] = *(const LAS bf16x8*)(kp + ks * 32); a[2 * ks + 1] = *(const LAS bf16x8*)(kp + 32 * KSTR + ks * 32); }
#pragma unroll
  for (int i = 0; i < 16; ++i) { s0[i] = bias; s1[i] = bias; }
  SBAR();
  __builtin_amdgcn_s_setprio(1);
#pragma unroll
  for (int ks = 0; ks < 4; ++ks) { s0 = MFMA32(a[2 * ks], q[ks], s0); s1 = MFMA32(a[2 * ks + 1], q[ks], s1); }
  __builtin_amdgcn_s_setprio(0);
  SBAR();
}
template <int KSTR> DI void qk64c(f32x16& s0, f32x16& s1, const lds8* kp, const bf16x8 (&q)[4], const f32x16& negm) {
  bf16x8 a[8];
#pragma unroll
  for (int ks = 0; ks < 4; ++ks) { a[2 * ks] = *(const LAS bf16x8*)(kp + ks * 32); a[2 * ks + 1] = *(const LAS bf16x8*)(kp + 32 * KSTR + ks * 32); }
  SBAR();
  __builtin_amdgcn_s_setprio(1);
  s0 = MFMA32(a[0], q[0], negm); s1 = MFMA32(a[1], q[0], negm);
#pragma unroll
  for (int ks = 1; ks < 4; ++ks) { s0 = MFMA32(a[2 * ks], q[ks], s0); s1 = MFMA32(a[2 * ks + 1], q[ks], s1); }
  __builtin_amdgcn_s_setprio(0);
  SBAR();
}
DI float rowmax32(const f32x16& s0, const f32x16& s1) {
  float a = fmaxf(fmaxf(s0[0], s0[1]), s1[0]), b = fmaxf(fmaxf(s0[2], s0[3]), s1[1]); a = fmaxf(fmaxf(a, s1[2]), s1[3]);
#pragma unroll
  for (int r = 4; r < 16; r += 4) { a = fmaxf(fmaxf(a, s0[r]), s0[r + 1]); b = fmaxf(fmaxf(b, s0[r + 2]), s0[r + 3]); a = fmaxf(fmaxf(a, s1[r]), s1[r + 1]); b = fmaxf(fmaxf(b, s1[r + 2]), s1[r + 3]); }
  const float m = fmaxf(a, b);
  return fmaxf(m, __shfl_xor(m, 32));
}
template <int NDVB, bool HAS_NEXT> DI void softmax_def(f32x16& sa0, f32x16& sa1, f32x16& sb0, f32x16& sb1, f32x16 (&O)[NDVB], float& muse, float& l, bool first, bf16x8 (&P)[4], bool check = true) {
  float mx = 0.f;
  if (check) mx = rowmax32(sa0, sa1);
  if (check && (first || __any(mx > 8.f))) {
    float dl = first ? mx : fmaxf(mx, 0.f);
    if (mx < -1e29f) dl = 0.f;
    const float alpha = __builtin_amdgcn_exp2f(-dl);
    muse += dl; l *= alpha;
#pragma unroll
    for (int i = 0; i < 16; ++i) { sa0[i] -= dl; sa1[i] -= dl; }
    if (HAS_NEXT) {
#pragma unroll
      for (int i = 0; i < 16; ++i) { sb0[i] -= dl; sb1[i] -= dl; }
    }
#pragma unroll
    for (int d = 0; d < NDVB; ++d)
#pragma unroll
      for (int i = 0; i < 16; ++i) O[d][i] *= alpha;
  }
  float sum = 0.f;
#pragma unroll
  for (int i = 0; i < 16; ++i) { sa0[i] = __builtin_amdgcn_exp2f(sa0[i]); sum += sa0[i]; }
#pragma unroll
  for (int i = 0; i < 16; ++i) { sa1[i] = __builtin_amdgcn_exp2f(sa1[i]); sum += sa1[i]; }
  l += sum;
  u32x4 w;
  w.x = cvtpk(sa0[0], sa0[1]); w.y = cvtpk(sa0[2], sa0[3]); w.z = cvtpk(sa0[4], sa0[5]); w.w = cvtpk(sa0[6], sa0[7]); P[0] = __builtin_bit_cast(bf16x8, w);
  w.x = cvtpk(sa0[8], sa0[9]); w.y = cvtpk(sa0[10], sa0[11]); w.z = cvtpk(sa0[12], sa0[13]); w.w = cvtpk(sa0[14], sa0[15]); P[1] = __builtin_bit_cast(bf16x8, w);
  w.x = cvtpk(sa1[0], sa1[1]); w.y = cvtpk(sa1[2], sa1[3]); w.z = cvtpk(sa1[4], sa1[5]); w.w = cvtpk(sa1[6], sa1[7]); P[2] = __builtin_bit_cast(bf16x8, w);
  w.x = cvtpk(sa1[8], sa1[9]); w.y = cvtpk(sa1[10], sa1[11]); w.z = cvtpk(sa1[12], sa1[13]); w.w = cvtpk(sa1[14], sa1[15]); P[3] = __builtin_bit_cast(bf16x8, w);
}
struct DaCtx { const bf16_t* kg; const bf16_t* vg; int sr0, sc0, sr1, sc1, koff, voff, qpos, h, qs, q0; };
template <bool LOAD2, bool MASK>
DI void da_step(lds8* lds, const DaCtx& cx, int t, const bf16x8 (&q)[4], f32x16 (&O)[4], float& muse, float& l, f32x16& negm) {
  u32x4 kr0, kr1, vr0, vr1;
  if (LOAD2) { const size_t ro = (size_t)(t + 2) * 64;
    kr0 = *(const u32x4*)(cx.kg + (ro + cx.sr0) * DM + cx.sc0 * 8); kr1 = *(const u32x4*)(cx.kg + (ro + cx.sr1) * DM + cx.sc1 * 8);
    vr0 = *(const u32x4*)(cx.vg + (ro + cx.sr0) * DM + cx.sc0 * 8); vr1 = *(const u32x4*)(cx.vg + (ro + cx.sr1) * DM + cx.sc1 * 8); }
  SBAR();
  const int st = t % 3, stn2 = (st == 0) ? 2 : st - 1;
  const bool cur_live = !MASK || 64 * t <= cx.q0 + 32 * cx.qs + 31;
  if (cur_live) {
    f32x16 sa0, sa1, du0, du1;
    qk64c<DA_KSTR>(sa0, sa1, lds + st * DA_STAGE + cx.koff, q, negm);
    if (MASK) {
      if (64 * t + 63 > cx.q0 + 32 * cx.qs) {
#pragma unroll
        for (int i = 0; i < 16; ++i) { const int key = 64 * t + crow(i, cx.h); if (key > cx.qpos) sa0[i] = NEG; if (key + 32 > cx.qpos) sa1[i] = NEG; }
      }
    }
    bf16x8 P[4];
    const float mprev = muse;
    softmax_def<4, false>(sa0, sa1, du0, du1, O, muse, l, t == 0, P, MASK || (t & 1) == 0);
    if (__any(muse != mprev)) {
#pragma unroll
      for (int i = 0; i < 16; ++i) negm[i] = -muse;
    }
    pv64<DA_KSTR, 4>(O, lds + st * DA_STAGE + cx.voff, P);
  }
  if (LOAD2) { lds8* b = lds + stn2 * DA_STAGE;
    *(LAS u32x4*)(b + cx.sr0 * DA_KSTR + cx.sc0 * 16) = kr0; *(LAS u32x4*)(b + cx.sr1 * DA_KSTR + cx.sc1 * 16) = kr1;
    *(LAS u32x4*)(b + 64 * DA_KSTR + cx.sr0 * DA_KSTR + cx.sc0 * 16) = vr0; *(LAS u32x4*)(b + 64 * DA_KSTR + cx.sr1 * DA_KSTR + cx.sc1 * 16) = vr1;
    __syncthreads(); }
}
DI void da_unit(const Params& p, lds8* lds, int bl, int hd, int qb, float lam) {
  int tid = threadIdx.x; asm volatile("" : "+v"(tid));
  const int lane = tid & 63, wid = __builtin_amdgcn_readfirstlane(tid >> 6);
  unsigned char* ws = p.ws;
  bf16_t* QDA = (bf16_t*)(ws + OFF_QDA); const bf16_t* KDA = (const bf16_t*)(ws + OFF_KDA); const bf16_t* VDA = (const bf16_t*)(ws + OFF_VDA);
  const int r = lane & 31, h = lane >> 5, qs = wid & 3, c = wid >> 2;
  const size_t rowbase = (size_t)bl * SEQ; const int q0 = qb * 128; const int qpos = q0 + 32 * qs + r;
  bf16x8 q[4];
  { const bf16_t* qp = QDA + (rowbase + qpos) * DM + hd * 128 + c * 64 + 8 * h;
#pragma unroll
    for (int ks = 0; ks < 4; ++ks) q[ks] = *(const bf16x8*)(qp + 16 * ks); }
  const int nt = 2 * (qb + 1);
  DaCtx cx;
  { const int ch0 = tid, ch1 = tid + 512; cx.sr0 = ch0 >> 4; cx.sc0 = ch0 & 15; cx.sr1 = ch1 >> 4; cx.sc1 = ch1 & 15; }
  cx.kg = KDA + rowbase * DM + hd * 128; cx.vg = VDA + rowbase * DM + hd * 128;
  cx.koff = r * DA_KSTR + h * 16 + c * 128;
  cx.voff = 64 * DA_KSTR + (4 * h + ((lane & 15) >> 2)) * DA_KSTR + ((lane >> 4) & 1) * 32 + (lane & 3) * 8;
  cx.qpos = qpos; cx.h = h; cx.qs = qs; cx.q0 = q0;
#pragma unroll
  for (int t0 = 0; t0 < 2; ++t0) { const size_t ro = (size_t)t0 * 64; lds8* b = lds + t0 * DA_STAGE;
    const u32x4 kr0 = *(const u32x4*)(cx.kg + (ro + cx.sr0) * DM + cx.sc0 * 8), kr1 = *(const u32x4*)(cx.kg + (ro + cx.sr1) * DM + cx.sc1 * 8);
    const u32x4 vr0 = *(const u32x4*)(cx.vg + (ro + cx.sr0) * DM + cx.sc0 * 8), vr1 = *(const u32x4*)(cx.vg + (ro + cx.sr1) * DM + cx.sc1 * 8);
    *(LAS u32x4*)(b + cx.sr0 * DA_KSTR + cx.sc0 * 16) = kr0; *(LAS u32x4*)(b + cx.sr1 * DA_KSTR + cx.sc1 * 16) = kr1;
    *(LAS u32x4*)(b + 64 * DA_KSTR + cx.sr0 * DA_KSTR + cx.sc0 * 16) = vr0; *(LAS u32x4*)(b + 64 * DA_KSTR + cx.sr1 * DA_KSTR + cx.sc1 * 16) = vr1; }
  __syncthreads();
  f32x16 O[4];
#pragma unroll
  for (int d = 0; d < 4; ++d)
#pragma unroll
    for (int i = 0; i < 16; ++i) O[d][i] = 0.f;
  float muse = 0.f, l = 0.f;
  int t = 0;
  f32x16 negm;
#pragma unroll
  for (int i = 0; i < 16; ++i) negm[i] = 0.f;
  for (; t + 2 < nt; ++t) da_step<true, false>(lds, cx, t, q, O, muse, l, negm);
  da_step<false, true>(lds, cx, t, q, O, muse, l, negm); ++t;
  da_step<false, true>(lds, cx, t, q, O, muse, l, negm);
  __syncthreads();
  const float lt = l + __shfl_xor(l, 32); const float inv = 1.f / lt;
  LAS float* ex = (LAS float*)lds;
  if (c == 1) {
#pragma unroll
    for (int d = 0; d < 4; ++d)
#pragma unroll
      for (int i = 0; i < 16; ++i) ex[((qs * 4 + d) * 16 + i) * 64 + lane] = O[d][i] * inv;
  }
  __syncthreads();
  if (c == 0) {
    float ss = 0.f;
#pragma unroll
    for (int d = 0; d < 4; ++d)
#pragma unroll
      for (int i = 0; i < 16; ++i) { const float o = O[d][i] * inv - lam * ex[((qs * 4 + d) * 16 + i) * 64 + lane]; O[d][i] = o; ss += o * o; }
    ss += __shfl_xor(ss, 32);
    const float rn = rsqrtf(ss * (1.f / 128.f) + EPSN) * 0.8f;
    const float* gn = p.da_head_norm + hd * 128;
    lds8* stg = lds + 65536 + qs * (32 * 272);
#pragma unroll
    for (int d = 0; d < 4; ++d)
#pragma unroll
      for (int ii = 0; ii < 4; ++ii) {
        const int dv = 32 * d + 8 * ii + 4 * h;
        const f32x4 g = *(const f32x4*)(gn + dv);
        u32x2 w; w.x = cvtpk(O[d][4 * ii] * rn * g[0], O[d][4 * ii + 1] * rn * g[1]); w.y = cvtpk(O[d][4 * ii + 2] * rn * g[2], O[d][4 * ii + 3] * rn * g[3]);
        *(LAS u32x2*)(stg + r * 272 + dv * 2) = w;
      }
    asm volatile("s_waitcnt lgkmcnt(0)" ::: "memory");
    bf16_t* yw = (bf16_t*)(ws + OFF_YDA) + (rowbase + q0 + 32 * qs) * DM + hd * 128;
#pragma unroll
    for (int i = 0; i < 8; ++i) { const int row = i * 4 + (lane >> 4), ch = lane & 15;
      const u32x4 v = *(const LAS u32x4*)(stg + row * 272 + ch * 16);
      *(u32x4*)(yw + (size_t)row * DM + ch * 8) = v; }
  }
  __syncthreads();
}

constexpr int NS_STR = 144, NS_STAGE = 2 * 64 * NS_STR, NS_IMPW = 3 * NS_STAGE, NS_SCORE = NS_IMPW + 8 * 32 * 33 * 4, NS_MASK = NS_SCORE + 32 * 33 * 4, NS_UMASK = NS_MASK + 128, NS_LIST = NS_UMASK + 16;
struct CmpCap { float qs[2][8], ls[2][8], mrec[2]; };
template <int MODE, int SLOT> DI void ns_valu(volatile LAS int* jl, int t, int ntl, int qpos, int h, int blk, f32x16& s0, f32x16& s1, f32x16& du0, f32x16& du1, f32x16 (&O)[2], float& muse, float& l, bf16x8 (&P)[4], CmpCap& cap) {
    if (t < ntl) {
      const int j = __builtin_amdgcn_readfirstlane(jl[t]);
      if (MODE == 0) {
        const int lim = ((qpos - 31) >> 4) - 64 * j - 4 * h;
#pragma unroll
        for (int i = 0; i < 16; ++i) { const int ci = (i & 3) + 8 * (i >> 2); if (ci > lim) s0[i] = NEG; if (ci + 32 > lim) s1[i] = NEG; }
      } else if (MODE == 1) {
        if (j == blk) {
          const int lim = qpos - 64 * j - 4 * h;
#pragma unroll
          for (int i = 0; i < 16; ++i) { const int ci = (i & 3) + 8 * (i >> 2); if (ci > lim) s0[i] = NEG; if (ci + 32 > lim) s1[i] = NEG; }
        }
      } else {
        if (j == blk || j + 8 == blk) {
          const int lim = qpos - 64 * j - 4 * h, lo = lim - 512;
#pragma unroll
          for (int i = 0; i < 16; ++i) { const int ci = (i & 3) + 8 * (i >> 2); if (ci > lim || ci <= lo) s0[i] = NEG; if (ci + 32 > lim || ci + 32 <= lo) s1[i] = NEG; }
        }
      }
      softmax_def<2, false>(s0, s1, du0, du1, O, muse, l, t == 0, P);
      if (MODE == 0) {
#pragma unroll
        for (int ii = 0; ii < 4; ++ii) { cap.qs[SLOT][ii] = (s0[4 * ii] + s0[4 * ii + 1]) + (s0[4 * ii + 2] + s0[4 * ii + 3]); cap.ls[SLOT][ii] = s0[4 * ii + 3];
          cap.qs[SLOT][4 + ii] = (s1[4 * ii] + s1[4 * ii + 1]) + (s1[4 * ii + 2] + s1[4 * ii + 3]); cap.ls[SLOT][4 + ii] = s1[4 * ii + 3]; }
        cap.mrec[SLOT] = muse;
      }
    }
}
template <int MODE>
DI void nsa_branch(lds8* lds, const bf16_t* kg, const bf16_t* vg, int pitch, unsigned tiles, const bf16x8 (&q)[4], int qpos, unsigned mybits, int blk,
                   f32x16 (&O)[2], float& muse, float& l, int tid, int lane, int grp, CmpCap& cap) {
  const int r = lane & 31, h = lane >> 5;
  const int sr = tid >> 3, sc = tid & 7;
  const int koff = r * NS_STR + h * 16;
  const int voff = 64 * NS_STR + (4 * h + ((lane & 15) >> 2)) * NS_STR + ((lane >> 4) & 1) * 32 + (lane & 3) * 8;
  volatile LAS int* jl = (volatile LAS int*)(lds + NS_LIST);
  tiles = __builtin_amdgcn_readfirstlane(tiles);
  const int ntl = __builtin_popcount(tiles);
  if (tid < 32) { unsigned below = tiles & ((1u << tid) - 1u); if ((tiles >> tid) & 1u) jl[__builtin_popcount(below)] = tid; }
  __syncthreads();
#pragma unroll
  for (int d = 0; d < 2; ++d)
#pragma unroll
    for (int i = 0; i < 16; ++i) O[d][i] = 0.f;
  muse = 0.f; l = 0.f;
  u32x4 kra, vra;
#define NS_GLOAD(k_, KR, VR) do { const int jj = __builtin_amdgcn_readfirstlane(jl[(k_)]); KR = *(const u32x4*)(kg + (size_t)(64 * jj + sr) * pitch + sc * 8); VR = *(const u32x4*)(vg + (size_t)(64 * jj + sr) * pitch + sc * 8); } while (0)
#define NS_LSTORE(st_, KR, VR) do { lds8* b = lds + (st_) * NS_STAGE; *(LAS u32x4*)(b + sr * NS_STR + sc * 16) = KR; *(LAS u32x4*)(b + 64 * NS_STR + sr * NS_STR + sc * 16) = VR; } while (0)
  NS_GLOAD(0, kra, vra); NS_LSTORE(0, kra, vra);
  if (ntl > 1) { NS_GLOAD(1, kra, vra); NS_LSTORE(1, kra, vra); }
  __syncthreads();
  f32x16 s0, s1, du0, du1; bf16x8 P[4];
  int st_cur = 0;
#define NS_STEP(KR, VR, SLOT_) do { \
    if (t + 2 < ntl) NS_GLOAD(t + 2, KR, VR); \
    SBAR(); \
    { float bias = -muse; \
      if (MODE == 1) { const int jq = __builtin_amdgcn_readfirstlane(jl[t]); if (!((mybits >> jq) & 1u)) bias = NEG; } \
      qk64b<NS_STR>(s0, s1, lds + st_cur * NS_STAGE + koff, q, bias); } \
    ns_valu<MODE, SLOT_>(jl, t, ntl, qpos, h, blk, s0, s1, du0, du1, O, muse, l, P, cap); \
    pv64<NS_STR, 2>(O, lds + st_cur * NS_STAGE + voff, P); \
    if (t + 2 < ntl) NS_LSTORE((st_cur == 0) ? 2 : st_cur - 1, KR, VR); \
    st_cur = (st_cur == 2) ? 0 : st_cur + 1; \
    __syncthreads(); } while (0)
  for (int t = 0; t < ntl; ++t) {
    NS_STEP(kra, vra, 0);
    ++t; if (t >= ntl) break;
    NS_STEP(kra, vra, 1);
  }
#undef NS_STEP
#undef NS_GLOAD
#undef NS_LSTORE
}
DI void nsa_unit(const Params& p, lds8* lds, int bl, int g, int qb32) {
  int tid = threadIdx.x; asm volatile("" : "+v"(tid));
  const int lane = tid & 63, wid = __builtin_amdgcn_readfirstlane(tid >> 6);
  unsigned char* ws = p.ws;
  bf16_t* QNS = (bf16_t*)(ws + OFF_QNS); const bf16_t* KSW = (const bf16_t*)(ws + OFF_KSW); const bf16_t* VSW = (const bf16_t*)(ws + OFF_VSW);
  const bf16_t* KC = (const bf16_t*)(ws + OFF_KC); const bf16_t* VC = (const bf16_t*)(ws + OFF_VC); const bf16_t* GNS = (const bf16_t*)(ws + OFF_GNS);
  const float* rope = (const float*)(ws + OFF_ROPE);
  const int r = lane & 31, h = lane >> 5; const int hh = g * 8 + wid;
  const size_t rowbase = (size_t)bl * SEQ; const int q0 = qb32 * 32, qpos = q0 + r, blk = q0 >> 6;
  bf16x8 qraw[4], qrot[4];
  { const bf16_t* qp = QNS + (rowbase + qpos) * DM + hh * 64 + 8 * h;
#pragma unroll
    for (int ks = 0; ks < 4; ++ks) qraw[ks] = *(const bf16x8*)(qp + 16 * ks); }
  const bf16_t* gp = GNS + (rowbase + qpos) * 64 + hh * 3;
  const float g0 = bf2f(gp[0]), g1 = bf2f(gp[1]), g2 = bf2f(gp[2]);
  f32x16 OT[2], O[2]; float m, l; const int grp = ((wid >> 2) ^ wid) & 1;
  const bf16_t* kc = KC + (size_t)(bl * 2 + g) * 128 * 64; const bf16_t* vc = VC + (size_t)(bl * 2 + g) * 128 * 64;
  CmpCap cap;
  nsa_branch<0>(lds, kc, vc, 64, 3u, qraw, qpos, 0u, blk, O, m, l, tid, lane, grp, cap);
  const float lt0 = l + __shfl_xor(l, 32); const float inv0 = lt0 > 0.f ? 1.f / lt0 : 0.f;
  { const float f = g0 * inv0;
#pragma unroll
    for (int d = 0; d < 2; ++d)
#pragma unroll
      for (int i = 0; i < 16; ++i) OT[d][i] = O[d][i] * f; }
  { LAS float* impw = (LAS float*)(lds + NS_IMPW) + (wid * 32 + r) * 33;
    float carry = 0.f;
#pragma unroll
    for (int kt = 0; kt < 2; ++kt) {
      const float scale = __builtin_amdgcn_exp2f(cap.mrec[kt] - m) * inv0;
#pragma unroll
      for (int kb = 0; kb < 2; ++kb)
#pragma unroll
        for (int ii = 0; ii < 4; ++ii) {
          const float qsum = cap.qs[kt][kb * 4 + ii] * scale, last = cap.ls[kt][kb * 4 + ii] * scale;
          const float other = __shfl_xor(last, 32);
          const int ub = 16 * kt + 8 * kb + 2 * ii;
          const float val = qsum + (h ? other : carry);
          carry = other;
          impw[ub + h] = val;
        }
    }
  }
  __syncthreads();
#pragma unroll
  for (int ks = 0; ks < 2; ++ks) {
    const float* rc = rope + qpos * 32 + 16 * ks + 8 * h;
    const f32x4 c0 = *(const f32x4*)rc, c1 = *(const f32x4*)(rc + 4), s0 = *(const f32x4*)(rc + 65536), s1 = *(const f32x4*)(rc + 65536 + 4);
    float o1[8], o2[8];
#pragma unroll
    for (int e = 0; e < 8; ++e) { const float x1 = bf2f((unsigned short)qraw[ks][e]), x2 = bf2f((unsigned short)qraw[ks + 2][e]); const float cc = e < 4 ? c0[e & 3] : c1[e & 3], sn = e < 4 ? s0[e & 3] : s1[e & 3];
      o1[e] = x1 * cc - x2 * sn; o2[e] = x2 * cc + x1 * sn; }
    u32x4 w; w.x = cvtpk(o1[0], o1[1]); w.y = cvtpk(o1[2], o1[3]); w.z = cvtpk(o1[4], o1[5]); w.w = cvtpk(o1[6], o1[7]); qrot[ks] = __builtin_bit_cast(bf16x8, w);
    w.x = cvtpk(o2[0], o2[1]); w.y = cvtpk(o2[2], o2[3]); w.z = cvtpk(o2[4], o2[5]); w.w = cvtpk(o2[6], o2[7]); qrot[ks + 2] = __builtin_bit_cast(bf16x8, w);
  }
  LAS float* score = (LAS float*)(lds + NS_SCORE); LAS unsigned* maskl = (LAS unsigned*)(lds + NS_MASK); LAS unsigned* umaskl = (LAS unsigned*)(lds + NS_UMASK);
  if (tid == 0) *umaskl = 0u;
  { const LAS float* iw = (const LAS float*)(lds + NS_IMPW);
    for (int idx = tid; idx < 32 * 32; idx += 512) { const int qq = idx >> 5, s = idx & 31; float a = 0.f;
#pragma unroll
      for (int w = 0; w < 8; ++w) a += iw[(w * 32 + qq) * 33 + s];
      if (s == 0 || s == blk || s == blk - 1) a = 1e9f;
      score[qq * 33 + s] = a; } }
  __syncthreads();
  { const int qq = tid >> 4, sb2 = (tid & 15) * 2; unsigned bits = 0u;
#pragma unroll
    for (int e = 0; e < 2; ++e) { const int s = sb2 + e;
      if (s <= blk) { const float v = score[qq * 33 + s]; int rank = 0;
        for (int s2 = 0; s2 <= blk; ++s2) { const float v2 = score[qq * 33 + s2]; rank += (v2 > v || (v2 == v && s2 < s)) ? 1 : 0; }
        if (rank < 16) bits |= 1u << s; } }
    bits |= __shfl_xor(bits, 1); bits |= __shfl_xor(bits, 2); bits |= __shfl_xor(bits, 4); bits |= __shfl_xor(bits, 8);
    if ((tid & 15) == 0) { maskl[qq] = bits; atomicOr((unsigned*)umaskl, bits); } }
  __syncthreads();
  const unsigned mybits = maskl[r]; const unsigned umask = *umaskl;
  nsa_branch<1>(lds, KSW + rowbase * 256 + g * 64, VSW + rowbase * 256 + g * 64, 256, umask, qrot, qpos, mybits, blk, O, m, l, tid, lane, grp, cap);
  { const float lt = l + __shfl_xor(l, 32); const float f = g1 / lt;
#pragma unroll
    for (int d = 0; d < 2; ++d)
#pragma unroll
      for (int i = 0; i < 16; ++i) OT[d][i] += O[d][i] * f; }
  { const int jlo = blk >= 8 ? blk - 8 : 0; const unsigned wt = (blk == 31 ? 0xffffffffu : ((1u << (blk + 1)) - 1u)) & ~((1u << jlo) - 1u);
    nsa_branch<2>(lds, KSW + rowbase * 256 + 128 + g * 64, VSW + rowbase * 256 + 128 + g * 64, 256, wt, qrot, qpos, 0u, blk, O, m, l, tid, lane, grp, cap); }
  { const float lt = l + __shfl_xor(l, 32); const float f = g2 / lt;
#pragma unroll
    for (int d = 0; d < 2; ++d)
#pragma unroll
      for (int i = 0; i < 16; ++i) OT[d][i] += O[d][i] * f; }
  bf16_t* yp = (bf16_t*)(ws + OFF_YNS) + (rowbase + qpos) * DM + hh * 64;
#pragma unroll
  for (int d = 0; d < 2; ++d)
#pragma unroll
    for (int ii = 0; ii < 4; ++ii) {
      const int dv = 32 * d + 8 * ii + 4 * h;
      u32x2 w; w.x = cvtpk(OT[d][4 * ii], OT[d][4 * ii + 1]); w.y = cvtpk(OT[d][4 * ii + 2], OT[d][4 * ii + 3]);
      *(u32x2*)(yp + dv) = w;
    }
}

#ifndef PH_FFN
#define PH_FFN 1
#endif
#ifndef PH_WIN
#define PH_WIN 1
#endif
#ifndef PH_CMP
#define PH_CMP 1
#endif
#ifndef PH_DA
#define PH_DA 1
#endif
#ifndef PH_NSA
#define PH_NSA 1
#endif
#ifndef PH_MRG1
#define PH_MRG1 1
#endif
#ifndef PH_OUT
#define PH_OUT 1
#endif
#ifndef REP_PRO
#define REP_PRO 1
#endif
#ifndef REP_SYNC
#define REP_SYNC 0
#endif
#ifndef REP_CMP
#define REP_CMP 1
#endif
#ifndef REP_UP
#define REP_UP 1
#endif
#ifndef REP_DA
#define REP_DA 1
#endif
#ifndef REP_NSA
#define REP_NSA 1
#endif
#ifndef PH_MRG
#define PH_MRG 1
#endif

#define XB_TMO      128
#define XB_XCNT(j)  (256  + 64 * (j))
#define XB_XSUB(j)  (1280 + 64 * (j))
#define XB_XGEN(j)  (2304 + 64 * (j))
#define XB_TOP      3328
#define XB_TOPGEN   3392
#define XCD_BAR_WORDS 3456
#define XB_SPIN_CAP (1u << 18)

__device__ __forceinline__ unsigned xb_ld(unsigned* p)              { return __hip_atomic_load(p, __ATOMIC_RELAXED, __HIP_MEMORY_SCOPE_AGENT); }
__device__ __forceinline__ unsigned xb_add(unsigned* p, unsigned v) { return __hip_atomic_fetch_add(p, v, __ATOMIC_RELAXED, __HIP_MEMORY_SCOPE_AGENT); }
__device__ __forceinline__ unsigned xb_xcc_id() { return (unsigned)__builtin_amdgcn_s_getreg((3 << 11) | 20) & 0xFu; }
#define XB_SPIN(cond, bar) do { unsigned _sp = 0; while (cond) { __builtin_amdgcn_s_sleep(1); \
    if ((++_sp & 255u) == 0u) { if (xb_ld(&(bar)[XB_TMO])) break; if (_sp > XB_SPIN_CAP) { atomicAdd(&(bar)[XB_TMO], 1u); break; } } } } while (0)

struct XcdBarrier {
    unsigned* bar; unsigned x;
    volatile LAS unsigned* st;
};

__device__ __forceinline__ XcdBarrier xcd_barrier_post(unsigned* bar, volatile LAS unsigned* st) {
    XcdBarrier b; b.bar = bar; b.x = xb_xcc_id(); b.st = st;
    if (threadIdx.x == 0) (void)xb_add(&bar[XB_XCNT(b.x)], 1u);
    return b;
}
__device__ __forceinline__ void xcd_barrier_complete(unsigned* bar, unsigned x, unsigned& nloc, unsigned& nx) {
    const unsigned G = gridDim.x * gridDim.y * gridDim.z;
    unsigned sum, cnt, mine, sp = 0u;
    for (;;) {
        sum = 0u; cnt = 0u; mine = 0u;
#pragma unroll
        for (unsigned j = 0; j < 16; ++j) { const unsigned c = xb_ld(&bar[XB_XCNT(j)]); sum += c; cnt += (c > 0u) ? 1u : 0u; mine = (j == x) ? c : mine; }
        if (sum == G) break;
        __builtin_amdgcn_s_sleep(1);
        if ((++sp & 255u) == 0u) { if (xb_ld(&bar[XB_TMO])) break; if (sp > XB_SPIN_CAP) { atomicAdd(&bar[XB_TMO], 1u); break; } }
    }
    nloc = mine > 0u ? mine : 1u; nx = cnt > 0u ? cnt : 1u;
}

__device__ __forceinline__ void xcd_barrier(const XcdBarrier& b) {
    asm volatile("s_waitcnt vmcnt(0)" ::: "memory");
    __syncthreads();
    if (threadIdx.x == 0) {
        unsigned* bar = b.bar;
        __builtin_amdgcn_s_waitcnt(0);
        unsigned nloc = b.st[0], nx = b.st[1];
        if (nloc == 0u) { xcd_barrier_complete(bar, b.x, nloc, nx); b.st[0] = nloc; b.st[1] = nx; }
        const unsigned old = xb_add(&bar[XB_XSUB(b.x)], 1u);
        const unsigned gen = old / nloc;
        if (old + 1u == (gen + 1u) * nloc) {
            __builtin_amdgcn_fence(__ATOMIC_RELEASE, "agent");
            asm volatile("s_waitcnt vmcnt(0)" ::: "memory");
            const unsigned og = xb_add(&bar[XB_TOP], 1u);
            const unsigned tg = og / nx;
            if (og + 1u == (tg + 1u) * nx) xb_add(&bar[XB_TOPGEN], 1u);
            else XB_SPIN(xb_ld(&bar[XB_TOPGEN]) == tg, bar);
            __builtin_amdgcn_fence(__ATOMIC_ACQUIRE, "agent");
            xb_add(&bar[XB_XGEN(b.x)], 1u);
            asm volatile("s_waitcnt vmcnt(0)" ::: "memory");
        } else {
            XB_SPIN(xb_ld(&bar[XB_XGEN(b.x)]) == gen, bar);
            __builtin_amdgcn_fence(__ATOMIC_ACQUIRE, "agent");
            asm volatile("s_waitcnt vmcnt(0)" ::: "memory");
        }
    }
    __syncthreads();
}

DI void ablk_prep_block(const Params& p, int pm) {
  int tid = threadIdx.x; asm volatile("" : "+v"(tid));
  const bf16_t* KVC = (const bf16_t*)(p.ws + OFF_KVC); bf16_t* AB = (bf16_t*)(p.ws + OFF_ABLK);
  const int kv = pm >> 4, bl = pm & 15;
  for (int idx = tid; idx < 256 * 256; idx += 512) {
    const int ch = idx & 255, rl = idx >> 8;
    const int g = rl & 1, n = rl >> 1; const int l = ch >> 3, d0 = (ch & 7) * 8;
    u32x4 o = {0u, 0u, 0u, 0u};
    if (n < 127) {
      const u32x4 v = *(const u32x4*)(KVC + ((size_t)bl * SEQ + 16 * n + l) * 256 + kv * 128 + g * 64 + d0);
      const float* ps = p.cmp_pos + (kv * 32 + l) * 64 + d0; const f32x4 p0 = *(const f32x4*)ps, p1 = *(const f32x4*)(ps + 4);
      o.x = cvtpk(bflo(v.x) + p0[0], bfhi(v.x) + p0[1]); o.y = cvtpk(bflo(v.y) + p0[2], bfhi(v.y) + p0[3]);
      o.z = cvtpk(bflo(v.z) + p1[0], bfhi(v.z) + p1[1]); o.w = cvtpk(bflo(v.w) + p1[2], bfhi(v.w) + p1[3]);
    }
    *(u32x4*)(AB + ((size_t)pm * 256 + rl) * 2048 + ch * 8) = o;
  }
}
DI void cmp_gemm2_block(const Params& p, lds8* lds, int pm) {
  int tid = threadIdx.x; asm volatile("" : "+v"(tid));
  const int kv = pm >> 4, bl = pm & 15;
  LAS float* wl = (LAS float*)lds;
  const float* w2 = p.cmp_w2 + (size_t)kv * 256 * 64;
  for (int i = tid; i < 256 * 64 / 4; i += 512) *(LAS f32x4*)(wl + i * 4) = *(const f32x4*)(w2 + i * 4);
  __syncthreads();
  const int rl = tid >> 1, dh = (tid & 1) * 32;
  const bf16_t* hr = (const bf16_t*)(p.ws + OFF_HID) + ((size_t)pm * 256 + rl) * 256;
  float a[32];
#pragma unroll
  for (int e = 0; e < 32; ++e) a[e] = 0.f;
#pragma unroll 1
  for (int j = 0; j < 256; j += 2) {
    const unsigned hv = *(const unsigned*)(hr + j);
    const float h0 = bflo(hv), h1 = bfhi(hv);
    const LAS float* w0 = wl + j * 64 + dh;
#pragma unroll
    for (int e4 = 0; e4 < 8; ++e4) { const f32x4 wa = *(const LAS f32x4*)(w0 + 4 * e4), wb = *(const LAS f32x4*)(w0 + 64 + 4 * e4);
      a[4 * e4] += h0 * wa[0] + h1 * wb[0]; a[4 * e4 + 1] += h0 * wa[1] + h1 * wb[1]; a[4 * e4 + 2] += h0 * wa[2] + h1 * wb[2]; a[4 * e4 + 3] += h0 * wa[3] + h1 * wb[3]; }
  }
  const int g = rl & 1, n = rl >> 1;
  bf16_t* dst = (bf16_t*)(p.ws + (kv ? OFF_VC : OFF_KC)) + ((size_t)(bl * 2 + g) * 128 + n) * 64 + dh;
#pragma unroll
  for (int e8 = 0; e8 < 4; ++e8) { u32x4 w; w.x = cvtpk(a[8 * e8], a[8 * e8 + 1]); w.y = cvtpk(a[8 * e8 + 2], a[8 * e8 + 3]); w.z = cvtpk(a[8 * e8 + 4], a[8 * e8 + 5]); w.w = cvtpk(a[8 * e8 + 6], a[8 * e8 + 7]);
    *(u32x4*)(dst + 8 * e8) = w; }
  __syncthreads();
}
#define BLOCK_SEAM() do { asm volatile("s_waitcnt vmcnt(0)" ::: "memory"); __syncthreads(); __builtin_amdgcn_fence(__ATOMIC_ACQUIRE, "agent"); asm volatile("s_waitcnt vmcnt(0)" ::: "memory"); } while (0)

__global__ void __launch_bounds__(512, 2) fwd_mega(Params p) {
  extern __shared__ __attribute__((aligned(16))) unsigned char lds_raw[];
  lds8* lds = (lds8*)lds_raw;
  cg::grid_group grid = cg::this_grid();
  const int G = gridDim.x, bid = blockIdx.x;
  const int NGW = G * 8, nthr = G * 512;
  unsigned char* ws = p.ws;
  float* ssq = (float*)(ws + OFF_SSQ);
  bf16_t* XB = (bf16_t*)(ws + OFF_XB); bf16_t* H = (bf16_t*)(ws + OFF_BIG);
  using pg8::Gemm; using pg8::StaticOrder;
  volatile LAS unsigned* bst = (volatile LAS unsigned*)(lds + 131072 + 256);
  if (threadIdx.x < 2) bst[threadIdx.x] = 0u;
  __syncthreads();
  (void)xcd_barrier_post((unsigned*)(ws + OFF_BAR), bst);
#define GSYNC() do { XcdBarrier b_; b_.bar = (unsigned*)(p.ws + OFF_BAR); b_.x = xb_xcc_id(); b_.st = (volatile LAS unsigned*)(lds + 131072 + 256); xcd_barrier(b_); } while (0)

  for (int rep = 0; rep < REP_PRO; ++rep) prologue(p, lds, NGW);
  if (p.ws == nullptr) grid.sync();
  GSYNC();
  for (int rep = 0; rep < REP_SYNC; ++rep) GSYNC();
#if PH_FFN
  for (int rep = 0; rep < REP_UP; ++rep)
  { Gemm g{XB, (const bf16_t*)(ws + OFF_W13_1), MTOK, 2 * DFF, DM}; StaticOrder S; S.init(MTOK, 2 * DFF, G, bid); EpiSwiGLU E{H, ssq};
    pg8::gemm_phase<EpiSwiGLU, StaticOrder, true, true>(lds, g, S, E); }
  GSYNC();
  { Gemm g{H, (const bf16_t*)(ws + OFF_W2_1), MTOK, DM, DFF}; StaticOrder S; S.init(MTOK, DM, G, bid); EpiResid E{XB, XB, ssq + MTOK, 0.5f, 0};
    pg8::gemm_phase<EpiResid, StaticOrder, true, true>(lds, g, S, E); }
  GSYNC();
#endif
  float lam;
  { float a = 0.f, b = 0.f;
    for (int i = 0; i < 64; ++i) { a += p.da_lambda[i] * p.da_lambda[64 + i]; b += p.da_lambda[128 + i] * p.da_lambda[192 + i]; }
    lam = __uint_as_float(__builtin_amdgcn_readfirstlane(__float_as_uint(__expf(a) - __expf(b) + 0.2f))); }
  for (int ck = 0; ck < NCHUNK; ++ck) {
    const int row_off = ck * MC;
#if PH_WIN
    { Gemm g{XB + (size_t)row_off * DM, (const bf16_t*)(ws + OFF_WIN), MC, NIN, DM}; StaticOrder S; S.init(MC, NIN, G, bid);
      EpiWin E{ssq + MTOK, row_off, (const float*)(ws + OFF_ROPE), (bf16_t*)(ws + OFF_QDA), (bf16_t*)(ws + OFF_KDA), (bf16_t*)(ws + OFF_VDA), (bf16_t*)(ws + OFF_QNS),
               (bf16_t*)(ws + OFF_KVC), (bf16_t*)(ws + OFF_KSW), (bf16_t*)(ws + OFF_VSW), (bf16_t*)(ws + OFF_GNS), (bf16_t*)(ws + OFF_GA), (bf16_t*)(ws + OFF_GB)};
      pg8::gemm_phase<EpiWin, StaticOrder, true, true>(lds, g, S, E); }
#endif
    GSYNC();
    volatile LAS unsigned* wq = (volatile LAS unsigned*)(lds + 131072 + 512);
    unsigned* qcnt = (unsigned*)(ws + OFF_BAR + 14336) + ck * 128;
    unsigned* cflag = (unsigned*)(ws + OFF_BAR + 15360) + ck * 64;
#if PH_CMP
    if (bid < 32) {
      for (int rep = 0; rep < REP_CMP; ++rep) {
      ablk_prep_block(p, bid);
      BLOCK_SEAM();
      { Gemm g{(const bf16_t*)(ws + OFF_ABLK), (const bf16_t*)(ws + OFF_W1C), 8192, 512, 2048}; CmpOrder S{bid}; EpiGelu E{(bf16_t*)(ws + OFF_HID)};
        pg8::gemm_phase<EpiGelu, CmpOrder, true, true>(lds, g, S, E); }
      BLOCK_SEAM();
      cmp_gemm2_block(p, lds, bid);
      }
      asm volatile("s_waitcnt vmcnt(0)" ::: "memory");
      __syncthreads();
      if (threadIdx.x == 0) { __builtin_amdgcn_fence(__ATOMIC_RELEASE, "agent"); asm volatile("s_waitcnt vmcnt(0)" ::: "memory");
        __hip_atomic_fetch_add(cflag, 1u, __ATOMIC_RELAXED, __HIP_MEMORY_SCOPE_AGENT); }
    }
#endif
#if PH_DA
    for (int rep = 0; rep < REP_DA; ++rep) {
      if (threadIdx.x == 0) *wq = atomicAdd(qcnt + 64 * rep, 1u);
      __syncthreads();
      int u = (int)*wq;
      __syncthreads();
      while (u < 2048) {
        unsigned nxt = 0u;
        if (threadIdx.x == 0) nxt = atomicAdd(qcnt + 64 * rep, 1u);
        const int qb = 15 - (u >> 7), bh = u & 127; da_unit(p, lds, bh >> 3, bh & 7, qb, lam);
        if (threadIdx.x == 0) *wq = nxt;
        __syncthreads();
        u = (int)*wq;
        __syncthreads();
      }
    }
#endif
    if (threadIdx.x == 0) { while (__hip_atomic_load(cflag, __ATOMIC_RELAXED, __HIP_MEMORY_SCOPE_AGENT) < 32u) __builtin_amdgcn_s_sleep(4);
      __builtin_amdgcn_fence(__ATOMIC_ACQUIRE, "agent"); asm volatile("s_waitcnt vmcnt(0)" ::: "memory"); }
    __syncthreads();
#if PH_NSA
    for (int rep = 0; rep < REP_NSA; ++rep) {
      if (threadIdx.x == 0) *wq = atomicAdd(qcnt + 32 + 64 * rep, 1u);
      __syncthreads();
      int u = (int)*wq;
      __syncthreads();
      while (u < 2048) {
        unsigned nxt = 0u;
        if (threadIdx.x == 0) nxt = atomicAdd(qcnt + 32 + 64 * rep, 1u);
        const int qb32 = 63 - (u >> 5), bg = u & 31; nsa_unit(p, lds, bg >> 1, bg & 1, qb32);
        if (threadIdx.x == 0) *wq = nxt;
        __syncthreads();
        u = (int)*wq;
        __syncthreads();
      }
    }
#endif
    GSYNC();
#if PH_MRG
    { Gemm g{(const bf16_t*)(ws + OFF_YDA), (const bf16_t*)(ws + OFF_WPD), MC, DM, DM}; StaticOrder S; S.init(MC, DM, G, bid); EpiMerge<0> E{(const bf16_t*)(ws + OFF_GA), (bf16_t*)(ws + OFF_MRG)};
      pg8::gemm_phase<EpiMerge<0>, StaticOrder, true, true>(lds, g, S, E); }
#if PH_MRG1
    { Gemm g{(const bf16_t*)(ws + OFF_YNS), (const bf16_t*)(ws + OFF_WPN), MC, DM, DM}; StaticOrder S; S.init(MC, DM, G, bid); EpiMerge<1> E{(const bf16_t*)(ws + OFF_GB), (bf16_t*)(ws + OFF_MRG)};
      pg8::gemm_phase<EpiMerge<1>, StaticOrder, true, true>(lds, g, S, E); }
#endif
    GSYNC();
#if PH_OUT
    { Gemm g{(const bf16_t*)(ws + OFF_MRG), (const bf16_t*)(ws + OFF_WOUT), MC, DM, DM}; StaticOrder S; S.init(MC, DM, G, bid); EpiResid E{XB, XB, ssq + 2 * MTOK, 1.0f, row_off};
      pg8::gemm_phase<EpiResid, StaticOrder, true, true>(lds, g, S, E); }
#endif
#endif
    GSYNC();
  }
#if PH_FFN
  { Gemm g{XB, (const bf16_t*)(ws + OFF_W13_2), MTOK, 2 * DFF, DM}; StaticOrder S; S.init(MTOK, 2 * DFF, G, bid); EpiSwiGLU E{H, ssq + 2 * MTOK};
    pg8::gemm_phase<EpiSwiGLU, StaticOrder, true, true>(lds, g, S, E); }
  GSYNC();
  { Gemm g{H, (const bf16_t*)(ws + OFF_W2_2), MTOK, DM, DFF}; StaticOrder S; S.init(MTOK, DM, G, bid); EpiResid E{XB, XB, ssq + 3 * MTOK, 0.5f, 0};
    pg8::gemm_phase<EpiResid, StaticOrder, true, true>(lds, g, S, E); }
#endif
  GSYNC();
  { int tidf = threadIdx.x; asm volatile("" : "+v"(tidf)); const int lane = tidf & 63; const int gw = bid * 8 + (tidf >> 6);
    for (int m = gw; m < MTOK; m += 2 * NGW) {
      const int m2 = (m + NGW < MTOK) ? m + NGW : m;
      const float q1 = ssq[3 * MTOK + m], q2 = ssq[3 * MTOK + m2];
      const u32x4* xr = (const u32x4*)(XB + (size_t)m * DM) + lane; const u32x4* xr2 = (const u32x4*)(XB + (size_t)m2 * DM) + lane;
      const u32x4 va0 = xr[0], va1 = xr[64], vb0 = xr2[0], vb1 = xr2[64];
      const f32x4* gr = (const f32x4*)p.final_norm;
#pragma unroll
      for (int rr = 0; rr < 2; ++rr) {
        if (rr == 1 && m2 == m) break;
        const float rstd = rsqrtf((rr ? q2 : q1) * (1.f / DM) + EPSN);
        f32x4* orow = (f32x4*)(p.out + (size_t)(rr ? m2 : m) * DM);
#pragma unroll
        for (int j = 0; j < 2; ++j) { const u32x4 v = rr ? (j ? vb1 : vb0) : (j ? va1 : va0); const int c4 = (64 * j + lane) * 2;
          const f32x4 g0 = gr[c4], g1 = gr[c4 + 1];
          f32x4 o0, o1; o0[0] = bflo(v.x) * rstd * g0[0]; o0[1] = bfhi(v.x) * rstd * g0[1]; o0[2] = bflo(v.y) * rstd * g0[2]; o0[3] = bfhi(v.y) * rstd * g0[3];
          o1[0] = bflo(v.z) * rstd * g1[0]; o1[1] = bfhi(v.z) * rstd * g1[1]; o1[2] = bflo(v.w) * rstd * g1[2]; o1[3] = bfhi(v.w) * rstd * g1[3];
          __builtin_nontemporal_store(o0, &orow[c4]); __builtin_nontemporal_store(o1, &orow[c4 + 1]); }
      }
    } }
}

extern "C" void kernel_launch(void* const* d_in, const int* in_sizes, int n_in, void* d_out, int out_size, void* d_ws, size_t ws_size, hipStream_t stream) {
  constexpr int LDSB = 147456;
  static int grid_blocks = 0;
  if (!grid_blocks) {
    if (n_in != 20 || ws_size < WS_END || ws_size < OFF_BIG + (size_t)MTOK * DFF * 2) { fprintf(stderr, "kernel_launch: unexpected inputs / workspace (%d inputs, %zu bytes)\n", n_in, ws_size); grid_blocks = -1; return; }
    int dev = 0, cus = 0, per_cu = 0;
    (void)hipGetDevice(&dev);
    (void)hipDeviceGetAttribute(&cus, hipDeviceAttributeMultiprocessorCount, dev);
    (void)hipFuncSetAttribute((const void*)fwd_mega, hipFuncAttributeMaxDynamicSharedMemorySize, LDSB);
    (void)hipOccupancyMaxActiveBlocksPerMultiprocessor(&per_cu, (const void*)fwd_mega, 512, LDSB);
    if (per_cu < 1) per_cu = 1;
    grid_blocks = cus * per_cu;
  }
  if (grid_blocks < 0) return;
  Params p{};
  const float** pp = (const float**)&p;
  for (int i = 0; i < 20; ++i) pp[i] = (const float*)d_in[i];
  p.out = (float*)d_out; p.ws = (unsigned char*)d_ws;
  (void)hipMemsetAsync((unsigned char*)d_ws + OFF_BAR, 0, 16384, stream);
  void* args[] = {&p};
  hipError_t e = hipLaunchCooperativeKernel((void*)fwd_mega, dim3(grid_blocks), dim3(512), args, LDSB, stream);
  if (e != hipSuccess) fprintf(stderr, "cooperative launch failed: %s (grid %d)\n", hipGetErrorString(e), grid_blocks);
}
```

```cpp
#include <hip/hip_runtime.h>
#include <hip/hip_cooperative_groups.h>
#include <cstdio>
#include <cstdint>
namespace cg = cooperative_groups;
namespace pg8 {
#define PG8_LAS __attribute__((address_space(3)))
typedef unsigned short bf16_t;
typedef short bf16x8 __attribute__((ext_vector_type(8)));
typedef float f32x4 __attribute__((ext_vector_type(4)));
typedef unsigned u32x4 __attribute__((ext_vector_type(4)));
constexpr int BM = 256, BK = 64, HALF = 128, HTB = HALF * BK * 2  , STAGE_BYTES = 8 * HTB, NXCD = 8, WGM = 8;

__host__ __device__ __forceinline__ int lds_byte(int r, int c) { const int st = (r >> 4) * 2 + (c >> 5), rr = r & 15, cc = c & 31, ob = rr * 64 + cc * 2; return st * 1024 + (ob ^ (((ob >> 9) & 1) << 5)); }
__host__ __device__ __forceinline__ void stage_rc(int b, int& R, int& C) { const int st = b / 1024, sb = b % 1024, swz = sb ^ (((sb >> 9) & 1) << 5); R = (st >> 1) * 16 + swz / 64; C = (st & 1) * 32 + (swz % 64) / 2; }
__host__ __device__ __forceinline__ int perm32(int rho) { const int n = rho >> 4, i = rho & 15; return 8 * (i >> 2) + 4 * n + (i & 3); }

struct Unit { int pm, pn; };
struct Gemm { const bf16_t* A; const bf16_t* Bt; int M, N, K; };

struct StaticOrder {
    int nM, nN, nwg, G, c;
    __host__ __device__ void init(int M, int N, int G_, int c_) { nM = M / BM; nN = N / BM; nwg = nM * nN; G = G_; c = c_; }
    __host__ __device__ bool next(int i, Unit& u) const {
        const long L = (long)i * G + c; if (L >= nwg) return false;
        int wgid = (int)L; { const int q = nwg / NXCD, r = nwg % NXCD, xcd = wgid % NXCD, off = wgid / NXCD; wgid = (xcd < r ? xcd * (q + 1) : r * (q + 1) + (xcd - r) * q) + off; }
        const int nig = WGM * nN, gid = wgid / nig, fm = gid * WGM, gsz = (nM - fm) < WGM ? (nM - fm) : WGM;
        u.pm = fm + ((wgid % nig) % gsz); u.pn = (wgid % nig) / gsz; return true;
    }
    __device__ __forceinline__ void a_ready(const Unit&) const {}
    __device__ __forceinline__ void done(const Unit&) const {}
};

__device__ __forceinline__ unsigned cvt_pk_bf16(float lo, float hi) { unsigned r; asm volatile("v_cvt_pk_bf16_f32 %0, %1, %2" : "=v"(r) : "v"(lo), "v"(hi)); return r; }
template <class Epi, class Sched, bool ALIGN_EPI = false, bool SP2 = false>
__device__ __forceinline__ void gemm_phase(PG8_LAS unsigned char* lds, const Gemm g, const Sched& S, const Epi& E) {
    int tid_ = threadIdx.x; asm volatile("" : "+v"(tid_));
    const int tid = tid_, wid = __builtin_amdgcn_readfirstlane(tid >> 6), lane = tid & 63, wr = wid >> 2, wc = wid & 3, fr = lane & 15, fq = lane >> 4;
    const int K = g.K, nt = K / BK;
    unsigned voffA[2], voffB[2];
#pragma unroll
    for (int i = 0; i < 2; ++i) { int R, C; stage_rc(tid * 16 + i * 8192, R, C); const int Rb = Epi::PERM ? ((R & ~31) + perm32(R & 31)) : R;
        voffA[i] = (unsigned)(R * K + C) * 2u; voffB[i] = (unsigned)(Rb * K + C) * 2u; }
    const size_t kstep = (size_t)(BK * 2);
    const size_t hstep = (size_t)HALF * K * 2;
    const size_t tstep = 2 * hstep;
    const unsigned ldsw = (unsigned)wid * 1024u;
    const int aoff = lds_byte(wr * 64 + fr, fq * 8), boff = lds_byte(wc * 32 + fr, fq * 8);
#define PG8_SA(b, h) (((b) * 2 + (h)) * HTB)
#define PG8_SB(b, h) ((4 + (b) * 2 + (h)) * HTB)
#define PG8_STAGE(bufoff, gbase, voff) do { _Pragma("unroll") for (int _i = 0; _i < 2; ++_i) \
        __builtin_amdgcn_global_load_lds((const unsigned*)((const char*)(gbase) + (voff)[_i]), (PG8_LAS unsigned*)(lds + (bufoff) + ldsw + _i * 8192), 16, 0, 0); } while (0)
#define PG8_LDA(dst, b, h) do { _Pragma("unroll") for (int m = 0; m < 4; ++m) _Pragma("unroll") for (int k = 0; k < 2; ++k) dst[m][k] = *(const PG8_LAS bf16x8*)(lds + PG8_SA(b, h) + aoff + m * 2048 + k * 1024); } while (0)
#define PG8_LDB(dst, b, h) do { _Pragma("unroll") for (int n = 0; n < 2; ++n) _Pragma("unroll") for (int k = 0; k < 2; ++k) dst[n][k] = *(const PG8_LAS bf16x8*)(lds + PG8_SB(b, h) + boff + n * 2048 + k * 1024); } while (0)
#define PG8_MMA(ai, bj, At, Bt) do { __builtin_amdgcn_s_setprio(1); _Pragma("unroll") for (int m = 0; m < 4; ++m) _Pragma("unroll") for (int n = 0; n < 2; ++n) _Pragma("unroll") for (int k = 0; k < 2; ++k) \
        acc[ai][bj][m][n] = __builtin_amdgcn_mfma_f32_16x16x32_bf16(Bt[n][k], At[m][k], acc[ai][bj][m][n], 0, 0, 0); __builtin_amdgcn_s_setprio(0); } while (0)
#define PG8_WAIT_V(n) asm volatile("s_waitcnt vmcnt(" #n ")" ::: "memory")
#define PG8_WAIT_L(n) asm volatile("s_waitcnt lgkmcnt(" #n ")" ::: "memory")
#define PG8_BAR __builtin_amdgcn_s_barrier()
#define PG8_SCHED __builtin_amdgcn_sched_barrier(0)
    Unit cur, nxt; int ui = 0;
    if (!S.next(0, cur)) return;
    f32x4 acc[2][2][4][2];
#pragma unroll
    for (int a = 0; a < 2; ++a)
#pragma unroll
        for (int b = 0; b < 2; ++b)
#pragma unroll
            for (int m = 0; m < 4; ++m)
#pragma unroll
                for (int n = 0; n < 2; ++n) acc[a][b][m][n] = (f32x4){0.f, 0.f, 0.f, 0.f};
    bf16x8 At[4][2], B0[2][2], B1[2][2];
    const char* cA = (const char*)g.A + (size_t)cur.pm * tstep; const char* cB = (const char*)g.Bt + (size_t)cur.pn * tstep;
    S.a_ready(cur);
    if constexpr (SP2) {
        PG8_STAGE(PG8_SB(0, 0), cB, voffB); PG8_STAGE(PG8_SB(0, 1), cB + hstep, voffB); PG8_STAGE(PG8_SA(0, 0), cA, voffA); PG8_STAGE(PG8_SA(0, 1), cA + hstep, voffA);
        if (wr == 1) PG8_BAR;
        PG8_WAIT_V(2); PG8_BAR;
        PG8_STAGE(PG8_SB(1, 0), cB + kstep, voffB); PG8_STAGE(PG8_SA(1, 0), cA + kstep, voffA); PG8_STAGE(PG8_SB(1, 1), cB + hstep + kstep, voffB);
        PG8_WAIT_V(6); PG8_BAR;
    } else {
        PG8_STAGE(PG8_SB(0, 0), cB, voffB); PG8_STAGE(PG8_SA(0, 0), cA, voffA); PG8_STAGE(PG8_SB(0, 1), cB + hstep, voffB); PG8_STAGE(PG8_SA(0, 1), cA + hstep, voffA);
        if (wr == 1) PG8_BAR;
        PG8_WAIT_V(4); PG8_BAR;
        PG8_STAGE(PG8_SB(1, 0), cB + kstep, voffB); PG8_STAGE(PG8_SA(1, 0), cA + kstep, voffA); PG8_STAGE(PG8_SB(1, 1), cB + hstep + kstep, voffB);
        PG8_WAIT_V(6); PG8_BAR;
    }
    for (;;) {
        const bool has_next = S.next(ui + 1, nxt);
        const char* nA = has_next ? (const char*)g.A + (size_t)nxt.pm * tstep : cA; const char* nB = has_next ? (const char*)g.Bt + (size_t)nxt.pn * tstep : cB;
        for (int t = 0; t < nt; t += 2) {
            const bool last = (t == nt - 2);
            const char* a1 = cA + (size_t)(t + 1) * kstep;
            const char* a2 = last ? nA : cA + (size_t)(t + 2) * kstep; const char* b2 = last ? nB : cB + (size_t)(t + 2) * kstep;
            const char* a3 = a2 + kstep; const char* b3 = b2 + kstep;
            if (last && has_next) S.a_ready(nxt);
            if constexpr (SP2) {
            PG8_LDB(B0, 0, 0); PG8_LDB(B1, 0, 1); PG8_SCHED; PG8_LDA(At, 0, 0); PG8_STAGE(PG8_SA(1, 1), a1 + hstep, voffA);
            PG8_WAIT_V(8); PG8_WAIT_L(0); PG8_BAR; PG8_MMA(0, 0, At, B0); PG8_MMA(0, 1, At, B1); PG8_BAR; PG8_SCHED;
            PG8_LDA(At, 0, 1); PG8_STAGE(PG8_SB(0, 0), b2, voffB); PG8_STAGE(PG8_SB(0, 1), b2 + hstep, voffB); PG8_STAGE(PG8_SA(0, 0), a2, voffA);
            PG8_WAIT_V(8); PG8_WAIT_L(0); PG8_BAR; PG8_MMA(1, 0, At, B0); PG8_MMA(1, 1, At, B1); PG8_BAR; PG8_SCHED;
            PG8_LDB(B0, 1, 0); PG8_LDB(B1, 1, 1); PG8_SCHED; PG8_LDA(At, 1, 0); PG8_STAGE(PG8_SA(0, 1), a2 + hstep, voffA);
            PG8_WAIT_V(8); PG8_WAIT_L(0); PG8_BAR; PG8_MMA(0, 0, At, B0); PG8_MMA(0, 1, At, B1); PG8_BAR; PG8_SCHED;
            PG8_LDA(At, 1, 1); PG8_STAGE(PG8_SB(1, 0), b3, voffB); PG8_STAGE(PG8_SB(1, 1), b3 + hstep, voffB); PG8_STAGE(PG8_SA(1, 0), a3, voffA);
            PG8_WAIT_V(8); PG8_WAIT_L(0); PG8_BAR; PG8_MMA(1, 0, At, B0); PG8_MMA(1, 1, At, B1); PG8_BAR; PG8_SCHED;
            } else {
            PG8_LDB(B0, 0, 0); PG8_SCHED; PG8_LDA(At, 0, 0); PG8_STAGE(PG8_SA(1, 1), a1 + hstep, voffA);
            PG8_WAIT_L(8); PG8_BAR; PG8_WAIT_L(0); PG8_MMA(0, 0, At, B0); PG8_BAR; PG8_SCHED;
            PG8_LDB(B1, 0, 1); PG8_STAGE(PG8_SB(0, 0), b2, voffB);
            PG8_BAR; PG8_WAIT_L(0); PG8_MMA(0, 1, At, B1); PG8_BAR;
            PG8_LDA(At, 0, 1); PG8_STAGE(PG8_SA(0, 0), a2, voffA);
            PG8_BAR; PG8_WAIT_L(0); PG8_MMA(1, 0, At, B0); PG8_BAR; PG8_SCHED;
            PG8_STAGE(PG8_SB(0, 1), b2 + hstep, voffB);
            PG8_WAIT_V(6); PG8_BAR; PG8_MMA(1, 1, At, B1); PG8_BAR;
            PG8_LDB(B0, 1, 0); PG8_SCHED; PG8_LDA(At, 1, 0); PG8_STAGE(PG8_SA(0, 1), a2 + hstep, voffA);
            PG8_WAIT_L(8); PG8_BAR; PG8_WAIT_L(0); PG8_MMA(0, 0, At, B0); PG8_BAR; PG8_SCHED;
            PG8_LDB(B1, 1, 1); PG8_STAGE(PG8_SB(1, 0), b3, voffB);
            PG8_BAR; PG8_WAIT_L(0); PG8_MMA(0, 1, At, B1); PG8_BAR;
            PG8_LDA(At, 1, 1); PG8_STAGE(PG8_SA(1, 0), a3, voffA);
            PG8_BAR; PG8_WAIT_L(0); PG8_MMA(1, 0, At, B0); PG8_BAR; PG8_SCHED;
            PG8_STAGE(PG8_SB(1, 1), b3 + hstep, voffB);
            PG8_WAIT_V(6); PG8_BAR; PG8_MMA(1, 1, At, B1); PG8_BAR;
            }
        }
        if constexpr (ALIGN_EPI) { if (wr == 0) PG8_BAR; }
        if constexpr (!Epi::AFTER_DRAIN) { E(acc, cur, wr, wc, fr, fq); S.done(cur); }
        if (!has_next) break;
#pragma unroll
        for (int a = 0; a < 2; ++a)
#pragma unroll
            for (int b = 0; b < 2; ++b)
#pragma unroll
                for (int m = 0; m < 4; ++m)
#pragma unroll
                    for (int n = 0; n < 2; ++n) acc[a][b][m][n] = (f32x4){0.f, 0.f, 0.f, 0.f};
        cur = nxt; cA = nA; cB = nB; ++ui;
        if constexpr (ALIGN_EPI) { if (wr == 1) PG8_BAR; }
    }
    PG8_WAIT_V(0);
    if constexpr (!ALIGN_EPI) { if (wr == 0) PG8_BAR; }
    PG8_BAR;
    if constexpr (Epi::AFTER_DRAIN) { E.fused(acc, cur, wr, wc, fr, fq, lds, wid, lane); S.done(cur); }
#undef PG8_SA
#undef PG8_SB
#undef PG8_STAGE
#undef PG8_LDA
#undef PG8_LDB
#undef PG8_MMA
#undef PG8_WAIT_V
#undef PG8_WAIT_L
#undef PG8_BAR
#undef PG8_SCHED
}
}

#define LAS __attribute__((address_space(3)))
typedef LAS unsigned char lds8;
typedef unsigned short bf16_t;
typedef short bf16x8 __attribute__((ext_vector_type(8)));
typedef short s16x4 __attribute__((ext_vector_type(4)));
typedef float f32x4 __attribute__((ext_vector_type(4)));
typedef float f32x16 __attribute__((ext_vector_type(16)));
typedef unsigned u32x4 __attribute__((ext_vector_type(4)));
typedef unsigned u32x2 __attribute__((ext_vector_type(2)));
typedef float f32x2_t __attribute__((ext_vector_type(2)));
typedef __bf16 bf16x2_t __attribute__((ext_vector_type(2)));

constexpr int DM = 1024, BATCH = 32, SEQ = 2048, MTOK = BATCH * SEQ, DFF = 2816;
constexpr int NCHUNK = 2, CB = BATCH / NCHUNK, MC = CB * SEQ;
constexpr int NIN = 7168;
constexpr float EPSN = 1e-6f;
constexpr float QSCALE = 0.125f * 1.4426950408889634f;
constexpr float NEG = -1e30f;
constexpr size_t MiB = 1u << 20;
constexpr size_t OFF_SSQ = 0;
constexpr size_t OFF_ROPE = 1 * MiB, OFF_BAR = 1 * MiB + 512 * 1024;
constexpr size_t OFF_W13_1 = 2 * MiB, OFF_W2_1 = 14 * MiB, OFF_W13_2 = 20 * MiB, OFF_W2_2 = 32 * MiB, OFF_WIN = 38 * MiB;
constexpr size_t OFF_WPD = 52 * MiB, OFF_WPN = 54 * MiB, OFF_WOUT = 56 * MiB, OFF_W1C = 58 * MiB;
constexpr size_t OFF_XB = 64 * MiB;
constexpr size_t OFF_BIG = 192 * MiB;
constexpr size_t OFF_QDA = OFF_BIG, OFF_KDA = OFF_QDA + 64 * MiB, OFF_VDA = OFF_KDA + 64 * MiB, OFF_QNS = OFF_VDA + 64 * MiB;
constexpr size_t OFF_GA = OFF_QNS + 64 * MiB, OFF_GB = OFF_GA + 64 * MiB, OFF_MRG = OFF_GB + 64 * MiB;
constexpr size_t OFF_KVC = OFF_MRG + 64 * MiB, OFF_KSW = OFF_KVC + 16 * MiB, OFF_VSW = OFF_KSW + 16 * MiB, OFF_GNS = OFF_VSW + 16 * MiB;
constexpr size_t OFF_ABLK = OFF_GNS + 4 * MiB, OFF_HID = OFF_ABLK + 32 * MiB, OFF_KC = OFF_HID + 4 * MiB, OFF_VC = OFF_KC + 1 * MiB;
constexpr size_t OFF_YDA = OFF_VC + 1 * MiB, OFF_YNS = OFF_YDA + 64 * MiB;
constexpr size_t WS_END = OFF_YNS + 64 * MiB;
static_assert(OFF_BIG + (size_t)MTOK * DFF * 2 <= 1024 * MiB && WS_END <= 1024 * MiB, "ws map");

__constant__ float c_invfreq[32] = {1.000000000e+00f, 7.498942018e-01f, 5.623413324e-01f, 4.216965139e-01f, 3.162277639e-01f, 2.371373922e-01f, 1.778279394e-01f, 1.333521456e-01f, 1.000000015e-01f, 7.498941571e-02f, 5.623412877e-02f, 4.216964915e-02f, 3.162277862e-02f, 2.371373586e-02f, 1.778279431e-02f, 1.333521493e-02f, 9.999999776e-03f, 7.498942316e-03f, 5.623413250e-03f, 4.216964822e-03f, 3.162277862e-03f, 2.371373819e-03f, 1.778279431e-03f, 1.333521446e-03f, 1.000000047e-03f, 7.498941850e-04f, 5.623413017e-04f, 4.216965463e-04f, 3.162277862e-04f, 2.371373848e-04f, 1.778279402e-04f, 1.333521504e-04f};

#define DI __device__ __forceinline__
DI unsigned cvtpk(float lo, float hi) { f32x2_t v = {lo, hi}; bf16x2_t b = __builtin_convertvector(v, bf16x2_t); return __builtin_bit_cast(unsigned, b); }
DI float bf2f(unsigned short u) { return __uint_as_float(((unsigned)u) << 16); }
DI float bflo(unsigned w) { return __uint_as_float(w << 16); }
DI float bfhi(unsigned w) { return __uint_as_float(w & 0xffff0000u); }
DI float sigmoidf_(float v) { return __builtin_amdgcn_rcpf(1.f + __builtin_amdgcn_exp2f(-v * 1.4426950408889634f)); }
DI u32x4 pack8(f32x4 a, f32x4 b) { u32x4 w; w.x = cvtpk(a[0], a[1]); w.y = cvtpk(a[2], a[3]); w.z = cvtpk(b[0], b[1]); w.w = cvtpk(b[2], b[3]); return w; }
DI int crow(int i, int h) { return (i & 3) + 8 * (i >> 2) + 4 * h; }
#define MFMA32(a, b, c) __builtin_amdgcn_mfma_f32_32x32x16_bf16((a), (b), (c), 0, 0, 0)

struct Params {
  const float *x, *ffn1_norm, *ffn1_w1, *ffn1_w3, *ffn1_w2, *mix_norm, *w_in, *da_lambda, *da_head_norm, *cmp_pos, *cmp_w1, *cmp_w2,
      *w_proj_da, *w_proj_nsa, *w_out, *ffn2_norm, *ffn2_w1, *ffn2_w3, *ffn2_w2, *final_norm;
  float* out; unsigned char* ws;
};

using pg8::Unit;
struct EpiSwiGLU {
  static constexpr bool PERM = true, AFTER_DRAIN = false;
  bf16_t* H; const float* ssq;
  DI void operator()(const f32x4 (&acc)[2][2][4][2], const Unit& u, int wr, int wc, int fr, int fq) const {
    const int row0 = u.pm * 256 + wr * 64 + fr; const int hcol = u.pn * 128 + wc * 32 + 8 * fq;
    float rs[8];
#pragma unroll
    for (int i = 0; i < 8; ++i) rs[i] = ssq[row0 + (i >> 2) * 128 + (i & 3) * 16];
#pragma unroll
    for (int ai = 0; ai < 2; ++ai)
#pragma unroll
      for (int m = 0; m < 4; ++m) {
        const int row = row0 + ai * 128 + m * 16;
        const float rstd = rsqrtf(rs[ai * 4 + m] * (1.f / DM) + EPSN);
        f32x4 o[2];
#pragma unroll
        for (int n = 0; n < 2; ++n) {
          const f32x4 a = acc[ai][0][m][n] * rstd, b = acc[ai][1][m][n] * rstd;
#pragma unroll
          for (int e = 0; e < 4; ++e) o[n][e] = a[e] * sigmoidf_(a[e]) * b[e];
        }
        __builtin_nontemporal_store(pack8(o[0], o[1]), (u32x4*)(H + (size_t)row * DFF + hcol));
      }
  }
};
struct EpiResid {
  static constexpr bool PERM = true, AFTER_DRAIN = false;
  const bf16_t* xin_b; bf16_t* xb; float* ssq_out; float scale; int row_off;
  DI void operator()(const f32x4 (&acc)[2][2][4][2], const Unit& u, int wr, int wc, int fr, int fq) const {
    const int row0 = row_off + u.pm * 256 + wr * 64 + fr; const int col0 = u.pn * 256 + wc * 32 + 8 * fq;
#pragma unroll
    for (int ai = 0; ai < 2; ++ai) {
      u32x4 xv[4][2];
#pragma unroll
      for (int m = 0; m < 4; ++m)
#pragma unroll
        for (int bj = 0; bj < 2; ++bj) xv[m][bj] = *(const u32x4*)(xin_b + (size_t)(row0 + ai * 128 + m * 16) * DM + col0 + bj * 128);
      asm volatile("" ::: "memory");
#pragma unroll
      for (int m = 0; m < 4; ++m) {
        const int row = row0 + ai * 128 + m * 16; float s = 0.f;
#pragma unroll
        for (int bj = 0; bj < 2; ++bj) {
          const size_t off = (size_t)row * DM + col0 + bj * 128;
          const u32x4 v = xv[m][bj];
          const f32x4 x0 = {bflo(v.x), bfhi(v.x), bflo(v.y), bfhi(v.y)}, x1 = {bflo(v.z), bfhi(v.z), bflo(v.w), bfhi(v.w)};
          const f32x4 y0 = x0 + acc[ai][bj][m][0] * scale, y1 = x1 + acc[ai][bj][m][1] * scale;
          *(u32x4*)(xb + off) = pack8(y0, y1);
          s += (y0[0] * y0[0] + y0[1] * y0[1]) + (y0[2] * y0[2] + y0[3] * y0[3]) + (y1[0] * y1[0] + y1[1] * y1[1]) + (y1[2] * y1[2] + y1[3] * y1[3]);
        }
        s += __shfl_xor(s, 16); s += __shfl_xor(s, 32);
        if (fq == 0) atomicAdd(ssq_out + row, s);
      }
      asm volatile("" ::: "memory");
    }
  }
};
struct EpiWin {
  static constexpr bool PERM = true, AFTER_DRAIN = false;
  const float* ssq; int row_off; const float* rope;
  bf16_t *QDA, *KDA, *VDA, *QNS, *KVC, *KSW, *VSW, *GNS, *GA, *GB;
  DI void operator()(const f32x4 (&acc)[2][2][4][2], const Unit& u, int wr, int wc, int fr, int fq) const {
    const int tl = u.pn; const int rowl0 = u.pm * 256 + wr * 64 + fr; const int c8 = wc * 32 + 8 * fq;
    if (tl < 8 || tl == 17) {
      bf16_t* dst; int colbase, pitch; float sc = 1.f;
      if (tl < 4) { dst = QDA; colbase = (tl * 4 + wc) * 64; pitch = DM; sc = QSCALE; }
      else if (tl < 8) { dst = KDA; colbase = ((tl - 4) * 4 + wc) * 64; pitch = DM; }
      else { dst = KSW; colbase = wc * 64; pitch = 256; }
#pragma unroll
      for (int ai = 0; ai < 2; ++ai)
#pragma unroll
        for (int m = 0; m < 4; ++m) {
          const int rowl = rowl0 + ai * 128 + m * 16; const int t = rowl & (SEQ - 1);
          const float rstd = rsqrtf(ssq[row_off + rowl] * (1.f / DM) + EPSN) * sc;
          const float* rc = rope + t * 32 + 8 * fq;
          const f32x4 c0 = *(const f32x4*)(rc), c1 = *(const f32x4*)(rc + 4), s0 = *(const f32x4*)(rc + 65536), s1 = *(const f32x4*)(rc + 65536 + 4);
          const f32x4 x1a = acc[ai][0][m][0] * rstd, x1b = acc[ai][0][m][1] * rstd, x2a = acc[ai][1][m][0] * rstd, x2b = acc[ai][1][m][1] * rstd;
          const f32x4 o1a = x1a * c0 - x2a * s0, o1b = x1b * c1 - x2b * s1, o2a = x2a * c0 + x1a * s0, o2b = x2b * c1 + x1b * s1;
          bf16_t* d = dst + (size_t)rowl * pitch + colbase + 8 * fq;
          *(u32x4*)(d) = pack8(o1a, o1b); *(u32x4*)(d + 32) = pack8(o2a, o2b);
          asm volatile("" ::: "memory");
        }
    } else {
      bf16_t* dst; int coloff = 0, pitch = DM, mode = 0;
      if (tl < 12) { dst = VDA; coloff = (tl - 8) * 256; }
      else if (tl < 16) { dst = QNS; coloff = (tl - 12) * 256; mode = 1; }
      else if (tl == 16) { dst = KVC; pitch = 256; }
      else if (tl == 18) { dst = VSW; pitch = 256; }
      else if (tl == 19) { dst = GNS; pitch = 64; mode = 2; }
      else if (tl < 24) { dst = GA; coloff = (tl - 20) * 256; mode = 2; }
      else { dst = GB; coloff = (tl - 24) * 256; mode = 2; }
#pragma unroll
      for (int ai = 0; ai < 2; ++ai)
#pragma unroll
        for (int m = 0; m < 4; ++m) {
          const int rowl = rowl0 + ai * 128 + m * 16;
          const float rstd = rsqrtf(ssq[row_off + rowl] * (1.f / DM) + EPSN) * (mode == 1 ? QSCALE : 1.f);
#pragma unroll
          for (int bj = 0; bj < 2; ++bj) {
            const int col = bj * 128 + c8;
            if (tl == 19 && col >= 64) continue;
            f32x4 v0 = acc[ai][bj][m][0] * rstd, v1 = acc[ai][bj][m][1] * rstd;
            if (mode == 2) {
#pragma unroll
              for (int e = 0; e < 4; ++e) { v0[e] = sigmoidf_(v0[e]); v1[e] = sigmoidf_(v1[e]); }
            }
            if (tl >= 20) __builtin_nontemporal_store(pack8(v0, v1), (u32x4*)(dst + (size_t)rowl * pitch + coloff + col));
            else *(u32x4*)(dst + (size_t)rowl * pitch + coloff + col) = pack8(v0, v1);
          }
        }
    }
  }
};
struct EpiGelu {
  static constexpr bool PERM = true, AFTER_DRAIN = false;
  bf16_t* HID;
  DI void operator()(const f32x4 (&acc)[2][2][4][2], const Unit& u, int wr, int wc, int fr, int fq) const {
    const int row0 = u.pm * 256 + wr * 64 + fr; const int c8 = wc * 32 + 8 * fq;
#pragma unroll
    for (int ai = 0; ai < 2; ++ai)
#pragma unroll
      for (int m = 0; m < 4; ++m)
#pragma unroll
        for (int bj = 0; bj < 2; ++bj) {
          f32x4 v[2];
#pragma unroll
          for (int n = 0; n < 2; ++n)
#pragma unroll
            for (int e = 0; e < 4; ++e) { const float a = acc[ai][bj][m][n][e]; const float z = 0.7978845608028654f * (a + 0.044715f * a * a * a); v[n][e] = a * sigmoidf_(2.f * z); }
          *(u32x4*)(HID + (size_t)(row0 + ai * 128 + m * 16) * 256 + bj * 128 + c8) = pack8(v[0], v[1]);
          asm volatile("" ::: "memory");
        }
  }
};
template <int STEP> struct EpiMerge {
  static constexpr bool PERM = true, AFTER_DRAIN = false;
  const bf16_t* gate; bf16_t* MRG;
  DI void operator()(const f32x4 (&acc)[2][2][4][2], const Unit& u, int wr, int wc, int fr, int fq) const {
    const int row0 = u.pm * 256 + wr * 64 + fr; const int col0 = u.pn * 256 + wc * 32 + 8 * fq;
#pragma unroll
    for (int ai = 0; ai < 2; ++ai) {
      u32x4 gv[4][2];
#pragma unroll
      for (int m = 0; m < 4; ++m)
#pragma unroll
        for (int bj = 0; bj < 2; ++bj) gv[m][bj] = *(const u32x4*)(gate + (size_t)(row0 + ai * 128 + m * 16) * DM + col0 + bj * 128);
#pragma unroll
      for (int mb = 0; mb < 4; mb += 2) {
        u32x4 pv[2][2];
        if (STEP == 1) {
#pragma unroll
          for (int mm = 0; mm < 2; ++mm)
#pragma unroll
            for (int bj = 0; bj < 2; ++bj) pv[mm][bj] = *(const u32x4*)(MRG + (size_t)(row0 + ai * 128 + (mb + mm) * 16) * DM + col0 + bj * 128);
        }
        asm volatile("" ::: "memory");
#pragma unroll
        for (int mm = 0; mm < 2; ++mm)
#pragma unroll
          for (int bj = 0; bj < 2; ++bj) {
            const int m = mb + mm;
            const size_t off = (size_t)(row0 + ai * 128 + m * 16) * DM + col0 + bj * 128;
            const u32x4 g = gv[m][bj];
            f32x4 v0 = acc[ai][bj][m][0], v1 = acc[ai][bj][m][1];
            v0[0] *= bflo(g.x); v0[1] *= bfhi(g.x); v0[2] *= bflo(g.y); v0[3] *= bfhi(g.y); v1[0] *= bflo(g.z); v1[1] *= bfhi(g.z); v1[2] *= bflo(g.w); v1[3] *= bfhi(g.w);
            if (STEP == 1) { const u32x4 p = pv[mm][bj];
              v0[0] += bflo(p.x); v0[1] += bfhi(p.x); v0[2] += bflo(p.y); v0[3] += bfhi(p.y); v1[0] += bflo(p.z); v1[1] += bfhi(p.z); v1[2] += bflo(p.w); v1[3] += bfhi(p.w); }
            *(u32x4*)(MRG + off) = pack8(v0, v1);
          }
        asm volatile("" ::: "memory");
      }
    }
  }
};
struct PanelOrder {
  int G, c;
  DI bool next(int i, Unit& u) const { const int pm = c + (i >> 2) * G; if (pm >= MTOK / 256) return false; u.pm = pm; u.pn = i & 3; return true; }
  DI void a_ready(const Unit&) const {}
  DI void done(const Unit&) const {}
};
struct CmpOrder {
  int c;
  DI bool next(int i, Unit& u) const { if (i > 0 || c >= 32) return false; u.pm = c; u.pn = c >> 4; return true; }
  DI void a_ready(const Unit&) const {}
  DI void done(const Unit&) const {}
};

DI void conv_item(const float* W, int ldw, int srccol0, const float* gain, int K, bf16_t* WT, int n0, int k0, LAS float* scr, int lane) {
  float vv[32];
#pragma unroll
  for (int i = 0; i < 32; ++i) { const int kk = 2 * i + (lane >> 5); vv[i] = W ? W[(size_t)(k0 + kk) * ldw + srccol0 + (lane & 31)] : 0.f; }
  if (gain) {
#pragma unroll
    for (int i = 0; i < 32; ++i) vv[i] *= gain[k0 + 2 * i + (lane >> 5)];
  }
#pragma unroll
  for (int i = 0; i < 32; ++i) scr[(2 * i + (lane >> 5)) * 33 + (lane & 31)] = vv[i];
  asm volatile("s_waitcnt lgkmcnt(0)" ::: "memory");
  const int c = lane & 7;
#pragma unroll
  for (int j = 0; j < 4; ++j) { const int n = (lane >> 3) + 8 * j; const LAS float* s = scr + (8 * c) * 33 + n;
    u32x4 o; o.x = cvtpk(s[0 * 33], s[1 * 33]); o.y = cvtpk(s[2 * 33], s[3 * 33]); o.z = cvtpk(s[4 * 33], s[5 * 33]); o.w = cvtpk(s[6 * 33], s[7 * 33]);
    *(u32x4*)(WT + (size_t)(n0 + n) * K + k0 + 8 * c) = o; }
  asm volatile("s_waitcnt lgkmcnt(0)" ::: "memory");
}
DI int win_src(int n0) {
  const int tl = n0 >> 8, j = n0 & 255;
  if (tl < 8 || (tl >= 12 && tl < 16)) {
    if (tl >= 12) return 3072 + (tl - 12) * 256 + j;
    const int base = (tl < 4) ? 0 : 1024; const int lt = tl & 3;
    return base + lt * 256 + ((j & 127) >> 5) * 64 + (j >> 7) * 32;
  }
  if (tl < 12) return 2048 + (tl - 8) * 256 + j;
  if (tl == 16) return 4096 + j;
  if (tl == 17) { const int hm = (j & 127) >> 5; const int b = (hm < 2) ? 4352 + hm * 64 : 4608 + (hm - 2) * 64; return b + (j >> 7) * 32; }
  if (tl == 18) return (j < 128) ? 4480 + j : 4736 + (j - 128);
  if (tl == 19) return (j < 64) ? 4864 + j : -1;
  if (tl < 24) return 4912 + (tl - 20) * 256 + j;
  return 5936 + (tl - 24) * 256 + j;
}
DI void prologue(const Params& p, lds8* lds, int NGW) {
  int tid = threadIdx.x; asm volatile("" : "+v"(tid));
  const int lane = tid & 63, wid = __builtin_amdgcn_readfirstlane(tid >> 6); const int gw = blockIdx.x * 8 + wid;
  unsigned char* ws = p.ws;
  LAS float* scr = (LAS float*)(lds + wid * 8704);
  constexpr int I13 = 16 * 176, I2 = 44 * 32, IWIN = 16 * 224, IP = 16 * 32, IC = 32 * 8;
  constexpr int NITEMS = 2 * I13 + 2 * I2 + IWIN + 3 * IP + 2 * IC;
  for (int it = gw; it < NITEMS; it += NGW) {
    int r = it;
    if (r < 2 * I13) { const int f = r / I13; r -= f * I13; const int kb = r / 176, nb = r % 176, n0 = nb * 32; const int tp = n0 >> 8, j = n0 & 255;
      const float* W = f ? (j < 128 ? p.ffn2_w1 : p.ffn2_w3) : (j < 128 ? p.ffn1_w1 : p.ffn1_w3);
      conv_item(W, DFF, tp * 128 + (j & 127), f ? p.ffn2_norm : p.ffn1_norm, DM, (bf16_t*)(ws + (f ? OFF_W13_2 : OFF_W13_1)), n0, kb * 64, scr, lane); continue; }
    r -= 2 * I13;
    if (r < 2 * I2) { const int f = r / I2; r -= f * I2; const int kb = r / 32, nb = r % 32;
      conv_item(f ? p.ffn2_w2 : p.ffn1_w2, DM, nb * 32, nullptr, DFF, (bf16_t*)(ws + (f ? OFF_W2_2 : OFF_W2_1)), nb * 32, kb * 64, scr, lane); continue; }
    r -= 2 * I2;
    if (r < IWIN) { const int kb = r / 224, nb = r % 224; const int sc = win_src(nb * 32);
      conv_item(sc >= 0 ? p.w_in : nullptr, 6960, sc, p.mix_norm, DM, (bf16_t*)(ws + OFF_WIN), nb * 32, kb * 64, scr, lane); continue; }
    r -= IWIN;
    if (r < 3 * IP) { const int f = r / IP; r -= f * IP; const int kb = r / 32, nb = r % 32;
      conv_item(f == 0 ? p.w_proj_da : (f == 1 ? p.w_proj_nsa : p.w_out), DM, nb * 32, nullptr, DM, (bf16_t*)(ws + (f == 0 ? OFF_WPD : (f == 1 ? OFF_WPN : OFF_WOUT))), nb * 32, kb * 64, scr, lane); continue; }
    r -= 3 * IP;
    { const int f = r / IC; r -= f * IC; const int kb = r / 8, nb = r % 8;
      conv_item(p.cmp_w1 + (size_t)f * 2048 * 256, 256, nb * 32, nullptr, 2048, (bf16_t*)(ws + OFF_W1C) + (size_t)f * 256 * 2048, nb * 32, kb * 64, scr, lane); }
  }
  float* ssq = (float*)(ws + OFF_SSQ); bf16_t* XB = (bf16_t*)(ws + OFF_XB);
  for (int m = gw; m < MTOK; m += 2 * NGW) {
    const int m2 = m + NGW; const bool has2 = m2 < MTOK;
    const f32x4* xr = (const f32x4*)(p.x + (size_t)m * DM) + lane; const f32x4* xr2 = (const f32x4*)(p.x + (size_t)(has2 ? m2 : m) * DM) + lane;
    f32x4 v[4], w[4];
#pragma unroll
    for (int j = 0; j < 4; ++j) { v[j] = __builtin_nontemporal_load(&xr[64 * j]); w[j] = __builtin_nontemporal_load(&xr2[64 * j]); }
    float s = 0.f, s2 = 0.f;
    u32x2* o8 = (u32x2*)(XB + (size_t)m * DM) + lane; u32x2* o82 = (u32x2*)(XB + (size_t)m2 * DM) + lane;
#pragma unroll
    for (int j = 0; j < 4; ++j) { s += (v[j][0] * v[j][0] + v[j][1] * v[j][1]) + (v[j][2] * v[j][2] + v[j][3] * v[j][3]); u32x2 o; o.x = cvtpk(v[j][0], v[j][1]); o.y = cvtpk(v[j][2], v[j][3]); o8[64 * j] = o;
      s2 += (w[j][0] * w[j][0] + w[j][1] * w[j][1]) + (w[j][2] * w[j][2] + w[j][3] * w[j][3]); if (has2) { u32x2 o2; o2.x = cvtpk(w[j][0], w[j][1]); o2.y = cvtpk(w[j][2], w[j][3]); o82[64 * j] = o2; } }
#pragma unroll
    for (int o = 1; o < 64; o <<= 1) { s += __shfl_xor(s, o); s2 += __shfl_xor(s2, o); }
    if (lane == 0) { ssq[m] = s; ssq[MTOK + m] = 0.f; ssq[2 * MTOK + m] = 0.f; ssq[3 * MTOK + m] = 0.f;
      if (has2) { ssq[m2] = s2; ssq[MTOK + m2] = 0.f; ssq[2 * MTOK + m2] = 0.f; ssq[3 * MTOK + m2] = 0.f; } }
  }
  float* rope = (float*)(ws + OFF_ROPE);
  for (int idx = gw * 64 + lane; idx < SEQ * 32; idx += NGW * 64) {
    const int t = idx >> 5, i = idx & 31;
    const float ang = (float)t * c_invfreq[i];
    const double ad = (double)ang; const double k = rint(ad * 0.15915494309189535); const float rr = (float)(ad - k * 6.283185307179586);
    rope[idx] = __cosf(rr); rope[65536 + idx] = __sinf(rr);
  }
}

#define SBAR() __builtin_amdgcn_sched_barrier(0)
template <int KSTR> DI void qk64(f32x16& s0, f32x16& s1, const lds8* kp, const bf16x8 (&q)[4]) {
  bf16x8 a[8];
#pragma unroll
  for (int ks = 0; ks < 4; ++ks) { a[2 * ks] = *(const LAS bf16x8*)(kp + ks * 32); a[2 * ks + 1] = *(const LAS bf16x8*)(kp + 32 * KSTR + ks * 32); }
#pragma unroll
  for (int i = 0; i < 16; ++i) { s0[i] = 0.f; s1[i] = 0.f; }
  SBAR();
  __builtin_amdgcn_s_setprio(1);
#pragma unroll
  for (int ks = 0; ks < 4; ++ks) { s0 = MFMA32(a[2 * ks], q[ks], s0); s1 = MFMA32(a[2 * ks + 1], q[ks], s1); }
  __builtin_amdgcn_s_setprio(0);
  SBAR();
}
DI s16x4 trrd(const lds8* p) { typedef short v4i16_t __attribute__((ext_vector_type(4))); return __builtin_bit_cast(s16x4, __builtin_amdgcn_ds_read_tr16_b64_v4i16((LAS v4i16_t*)p)); }
template <int VSTR, int NDVB> DI void pv64(f32x16 (&O)[NDVB], const lds8* vp, const bf16x8 (&P)[4]) {
  bf16x8 f[2][NDVB];
#pragma unroll
  for (int d = 0; d < NDVB; ++d) { const s16x4 lo = trrd(vp + d * 64), hi = trrd(vp + 8 * VSTR + d * 64); f[0][d] = __builtin_shufflevector(lo, hi, 0, 1, 2, 3, 4, 5, 6, 7); }
#pragma unroll
  for (int kk = 0; kk < 4; ++kk) {
    if (kk < 3) {
#pragma unroll
      for (int d = 0; d < NDVB; ++d) { const s16x4 lo = trrd(vp + (16 * (kk + 1)) * VSTR + d * 64), hi = trrd(vp + (16 * (kk + 1) + 8) * VSTR + d * 64);
        f[(kk + 1) & 1][d] = __builtin_shufflevector(lo, hi, 0, 1, 2, 3, 4, 5, 6, 7); }
    }
    SBAR();
    __builtin_amdgcn_s_setprio(1);
#pragma unroll
    for (int d = 0; d < NDVB; ++d) O[d] = MFMA32(f[kk & 1][d], P[kk], O[d]);
    __builtin_amdgcn_s_setprio(0);
    SBAR();
  }
}
DI float softmax_step(f32x16& s0, f32x16& s1, float& m, float& l, bf16x8 (&P)[4]) {
  float mx = fmaxf(s0[0], s1[0]);
#pragma unroll
  for (int i = 1; i < 16; ++i) mx = fmaxf(mx, fmaxf(s0[i], s1[i]));
  mx = fmaxf(mx, __shfl_xor(mx, 32));
  const float mnew = fmaxf(m, mx); const float muse = (mnew < -1e29f) ? 0.f : mnew;
  const float alpha = __builtin_amdgcn_exp2f(m - muse);
  m = mnew; float sum = 0.f;
#pragma unroll
  for (int i = 0; i < 16; ++i) { s0[i] = __builtin_amdgcn_exp2f(s0[i] - muse); s1[i] = __builtin_amdgcn_exp2f(s1[i] - muse); sum += s0[i] + s1[i]; }
  l = l * alpha + sum;
  u32x4 w;
  w.x = cvtpk(s0[0], s0[1]); w.y = cvtpk(s0[2], s0[3]); w.z = cvtpk(s0[4], s0[5]); w.w = cvtpk(s0[6], s0[7]); P[0] = __builtin_bit_cast(bf16x8, w);
  w.x = cvtpk(s0[8], s0[9]); w.y = cvtpk(s0[10], s0[11]); w.z = cvtpk(s0[12], s0[13]); w.w = cvtpk(s0[14], s0[15]); P[1] = __builtin_bit_cast(bf16x8, w);
  w.x = cvtpk(s1[0], s1[1]); w.y = cvtpk(s1[2], s1[3]); w.z = cvtpk(s1[4], s1[5]); w.w = cvtpk(s1[6], s1[7]); P[2] = __builtin_bit_cast(bf16x8, w);
  w.x = cvtpk(s1[8], s1[9]); w.y = cvtpk(s1[10], s1[11]); w.z = cvtpk(s1[12], s1[13]); w.w = cvtpk(s1[14], s1[15]); P[3] = __builtin_bit_cast(bf16x8, w);
  return alpha;
}

constexpr int DA_KSTR = 304, DA_STAGE = 2 * 64 * DA_KSTR;
template <int KSTR> DI void qk64b(f32x16& s0, f32x16& s1, const lds8* kp, const bf16x8 (&q)[4], float bias) {
  bf16x8 a[8];
#pragma unroll
  for (int ks = 0; ks < 4; ++ks) { a[2 * ks] = *(const LAS bf16x8*)(kp + ks * 32); a[2 * ks + 1] = *(const LAS bf16x8*)(kp + 32 * KSTR + ks * 32); }
#pragma unroll
  for (int i = 0; i < 16; ++i) { s0[i] = bias; s1[i] = bias; }
  SBAR();
  __builtin_amdgcn_s_setprio(1);
#pragma unroll
  for (int ks = 0; ks < 4; ++ks) { s0 = MFMA32(a[2 * ks], q[ks], s0); s1 = MFMA32(a[2 * ks + 1], q[ks], s1); }
  __builtin_amdgcn_s_setprio(0);
  SBAR();
}
template <int KSTR> DI void qk64c(f32x16& s0, f32x16& s1, const lds8* kp, const bf16x8 (&q)[4], const f32x16& negm) {
  bf16x8 a[8];
#pragma unroll
  for (int ks = 0; ks < 4; ++ks) { a[2 * ks] = *(const LAS bf16x8*)(kp + ks * 32); a[2 * ks + 1] = *(const LAS bf16x8*)(kp + 32 * KSTR + ks * 32); }
  SBAR();
  __builtin_amdgcn_s_setprio(1);
  s0 = MFMA32(a[0], q[0], negm); s1 = MFMA32(a[1], q[0], negm);
#pragma unroll
  for (int ks = 1; ks < 4; ++ks) { s0 = MFMA32(a[2 * ks], q[ks], s0); s1 = MFMA32(a[2 * ks + 1], q[ks], s1); }
  __builtin_amdgcn_s_setprio(0);
  SBAR();
}
DI float rowmax32(const f32x16& s0, const f32x16& s1) {
  float a = fmaxf(fmaxf(s0[0], s0[1]), s1[0]), b = fmaxf(fmaxf(s0[2], s0[3]), s1[1]); a = fmaxf(fmaxf(a, s1[2]), s1[3]);
#pragma unroll
  for (int r = 4; r < 16; r += 4) { a = fmaxf(fmaxf(a, s0[r]), s0[r + 1]); b = fmaxf(fmaxf(b, s0[r + 2]), s0[r + 3]); a = fmaxf(fmaxf(a, s1[r]), s1[r + 1]); b = fmaxf(fmaxf(b, s1[r + 2]), s1[r + 3]); }
  const float m = fmaxf(a, b);
  return fmaxf(m, __shfl_xor(m, 32));
}
template <int NDVB, bool HAS_NEXT> DI void softmax_def(f32x16& sa0, f32x16& sa1, f32x16& sb0, f32x16& sb1, f32x16 (&O)[NDVB], float& muse, float& l, bool first, bf16x8 (&P)[4], bool check = true) {
  float mx = 0.f;
  if (check) mx = rowmax32(sa0, sa1);
  if (check && (first || __any(mx > 8.f))) {
    float dl = first ? mx : fmaxf(mx, 0.f);
    if (mx < -1e29f) dl = 0.f;
    const float alpha = __builtin_amdgcn_exp2f(-dl);
    muse += dl; l *= alpha;
#pragma unroll
    for (int i = 0; i < 16; ++i) { sa0[i] -= dl; sa1[i] -= dl; }
    if (HAS_NEXT) {
#pragma unroll
      for (int i = 0; i < 16; ++i) { sb0[i] -= dl; sb1[i] -= dl; }
    }
#pragma unroll
    for (int d = 0; d < NDVB; ++d)
#pragma unroll
      for (int i = 0; i < 16; ++i) O[d][i] *= alpha;
  }
  float sum = 0.f;
#pragma unroll
  for (int i = 0; i < 16; ++i) { sa0[i] = __builtin_amdgcn_exp2f(sa0[i]); sum += sa0[i]; }
#pragma unroll
  for (int i = 0; i < 16; ++i) { sa1[i] = __builtin_amdgcn_exp2f(sa1[i]); sum += sa1[i]; }
  l += sum;
  u32x4 w;
  w.x = cvtpk(sa0[0], sa0[1]); w.y = cvtpk(sa0[2], sa0[3]); w.z = cvtpk(sa0[4], sa0[5]); w.w = cvtpk(sa0[6], sa0[7]); P[0] = __builtin_bit_cast(bf16x8, w);
  w.x = cvtpk(sa0[8], sa0[9]); w.y = cvtpk(sa0[10], sa0[11]); w.z = cvtpk(sa0[12], sa0[13]); w.w = cvtpk(sa0[14], sa0[15]); P[1] = __builtin_bit_cast(bf16x8, w);
  w.x = cvtpk(sa1[0], sa1[1]); w.y = cvtpk(sa1[2], sa1[3]); w.z = cvtpk(sa1[4], sa1[5]); w.w = cvtpk(sa1[6], sa1[7]); P[2] = __builtin_bit_cast(bf16x8, w);
  w.x = cvtpk(sa1[8], sa1[9]); w.y = cvtpk(sa1[10], sa1[11]); w.z = cvtpk(sa1[12], sa1[13]); w.w = cvtpk(sa1[14], sa1[15]); P[3] = __builtin_bit_cast(bf16x8, w);
}
struct DaCtx { const bf16_t* kg; const bf16_t* vg; int sr0, sc0, sr1, sc1, koff, voff, qpos, h, qs, q0; };
template <bool LOAD2, bool MASK>
DI void da_step(lds8* lds, const DaCtx& cx, int t, const bf16x8 (&q)[4], f32x16 (&O)[4], float& muse, float& l, f32x16& negm) {
  u32x4 kr0, kr1, vr0, vr1;
  if (LOAD2) { const size_t ro = (size_t)(t + 2) * 64;
    kr0 = *(const u32x4*)(cx.kg + (ro + cx.sr0) * DM + cx.sc0 * 8); kr1 = *(const u32x4*)(cx.kg + (ro + cx.sr1) * DM + cx.sc1 * 8);
    vr0 = *(const u32x4*)(cx.vg + (ro + cx.sr0) * DM + cx.sc0 * 8); vr1 = *(const u32x4*)(cx.vg + (ro + cx.sr1) * DM + cx.sc1 * 8); }
  SBAR();
  const int st = t % 3, stn2 = (st == 0) ? 2 : st - 1;
  const bool cur_live = !MASK || 64 * t <= cx.q0 + 32 * cx.qs + 31;
  if (cur_live) {
    f32x16 sa0, sa1, du0, du1;
    qk64c<DA_KSTR>(sa0, sa1, lds + st * DA_STAGE + cx.koff, q, negm);
    if (MASK) {
      if (64 * t + 63 > cx.q0 + 32 * cx.qs) {
#pragma unroll
        for (int i = 0; i < 16; ++i) { const int key = 64 * t + crow(i, cx.h); if (key > cx.qpos) sa0[i] = NEG; if (key + 32 > cx.qpos) sa1[i] = NEG; }
      }
    }
    bf16x8 P[4];
    const float mprev = muse;
    softmax_def<4, false>(sa0, sa1, du0, du1, O, muse, l, t == 0, P, MASK || (t & 1) == 0);
    if (__any(muse != mprev)) {
#pragma unroll
      for (int i = 0; i < 16; ++i) negm[i] = -muse;
    }
    pv64<DA_KSTR, 4>(O, lds + st * DA_STAGE + cx.voff, P);
  }
  if (LOAD2) { lds8* b = lds + stn2 * DA_STAGE;
    *(LAS u32x4*)(b + cx.sr0 * DA_KSTR + cx.sc0 * 16) = kr0; *(LAS u32x4*)(b + cx.sr1 * DA_KSTR + cx.sc1 * 16) = kr1;
    *(LAS u32x4*)(b + 64 * DA_KSTR + cx.sr0 * DA_KSTR + cx.sc0 * 16) = vr0; *(LAS u32x4*)(b + 64 * DA_KSTR + cx.sr1 * DA_KSTR + cx.sc1 * 16) = vr1;
    __syncthreads(); }
}
DI void da_unit(const Params& p, lds8* lds, int bl, int hd, int qb, float lam) {
  int tid = threadIdx.x; asm volatile("" : "+v"(tid));
  const int lane = tid & 63, wid = __builtin_amdgcn_readfirstlane(tid >> 6);
  unsigned char* ws = p.ws;
  bf16_t* QDA = (bf16_t*)(ws + OFF_QDA); const bf16_t* KDA = (const bf16_t*)(ws + OFF_KDA); const bf16_t* VDA = (const bf16_t*)(ws + OFF_VDA);
  const int r = lane & 31, h = lane >> 5, qs = wid & 3, c = wid >> 2;
  const size_t rowbase = (size_t)bl * SEQ; const int q0 = qb * 128; const int qpos = q0 + 32 * qs + r;
  bf16x8 q[4];
  { const bf16_t* qp = QDA + (rowbase + qpos) * DM + hd * 128 + c * 64 + 8 * h;
#pragma unroll
    for (int ks = 0; ks < 4; ++ks) q[ks] = *(const bf16x8*)(qp + 16 * ks); }
  const int nt = 2 * (qb + 1);
  DaCtx cx;
  { const int ch0 = tid, ch1 = tid + 512; cx.sr0 = ch0 >> 4; cx.sc0 = ch0 & 15; cx.sr1 = ch1 >> 4; cx.sc1 = ch1 & 15; }
  cx.kg = KDA + rowbase * DM + hd * 128; cx.vg = VDA + rowbase * DM + hd * 128;
  cx.koff = r * DA_KSTR + h * 16 + c * 128;
  cx.voff = 64 * DA_KSTR + (4 * h + ((lane & 15) >> 2)) * DA_KSTR + ((lane >> 4) & 1) * 32 + (lane & 3) * 8;
  cx.qpos = qpos; cx.h = h; cx.qs = qs; cx.q0 = q0;
#pragma unroll
  for (int t0 = 0; t0 < 2; ++t0) { const size_t ro = (size_t)t0 * 64; lds8* b = lds + t0 * DA_STAGE;
    const u32x4 kr0 = *(const u32x4*)(cx.kg + (ro + cx.sr0) * DM + cx.sc0 * 8), kr1 = *(const u32x4*)(cx.kg + (ro + cx.sr1) * DM + cx.sc1 * 8);
    const u32x4 vr0 = *(const u32x4*)(cx.vg + (ro + cx.sr0) * DM + cx.sc0 * 8), vr1 = *(const u32x4*)(cx.vg + (ro + cx.sr1) * DM + cx.sc1 * 8);
    *(LAS u32x4*)(b + cx.sr0 * DA_KSTR + cx.sc0 * 16) = kr0; *(LAS u32x4*)(b + cx.sr1 * DA_KSTR + cx.sc1 * 16) = kr1;
    *(LAS u32x4*)(b + 64 * DA_KSTR + cx.sr0 * DA_KSTR + cx.sc0 * 16) = vr0; *(LAS u32x4*)(b + 64 * DA_KSTR + cx.sr1 * DA_KSTR + cx.sc1 * 16) = vr1; }
  __syncthreads();
  f32x16 O[4];
#pragma unroll
  for (int d = 0; d < 4; ++d)
#pragma unroll
    for (int i = 0; i < 16; ++i) O[d][i] = 0.f;
  float muse = 0.f, l = 0.f;
  int t = 0;
  f32x16 negm;
#pragma unroll
  for (int i = 0; i < 16; ++i) negm[i] = 0.f;
  for (; t + 2 < nt; ++t) da_step<true, false>(lds, cx, t, q, O, muse, l, negm);
  da_step<false, true>(lds, cx, t, q, O, muse, l, negm); ++t;
  da_step<false, true>(lds, cx, t, q, O, muse, l, negm);
  __syncthreads();
  const float lt = l + __shfl_xor(l, 32); const float inv = 1.f / lt;
  LAS float* ex = (LAS float*)lds;
  if (c == 1) {
#pragma unroll
    for (int d = 0; d < 4; ++d)
#pragma unroll
      for (int i = 0; i < 16; ++i) ex[((qs * 4 + d) * 16 + i) * 64 + lane] = O[d][i] * inv;
  }
  __syncthreads();
  if (c == 0) {
    float ss = 0.f;
#pragma unroll
    for (int d = 0; d < 4; ++d)
#pragma unroll
      for (int i = 0; i < 16; ++i) { const float o = O[d][i] * inv - lam * ex[((qs * 4 + d) * 16 + i) * 64 + lane]; O[d][i] = o; ss += o * o; }
    ss += __shfl_xor(ss, 32);
    const float rn = rsqrtf(ss * (1.f / 128.f) + EPSN) * 0.8f;
    const float* gn = p.da_head_norm + hd * 128;
    lds8* stg = lds + 65536 + qs * (32 * 272);
#pragma unroll
    for (int d = 0; d < 4; ++d)
#pragma unroll
      for (int ii = 0; ii < 4; ++ii) {
        const int dv = 32 * d + 8 * ii + 4 * h;
        const f32x4 g = *(const f32x4*)(gn + dv);
        u32x2 w; w.x = cvtpk(O[d][4 * ii] * rn * g[0], O[d][4 * ii + 1] * rn * g[1]); w.y = cvtpk(O[d][4 * ii + 2] * rn * g[2], O[d][4 * ii + 3] * rn * g[3]);
        *(LAS u32x2*)(stg + r * 272 + dv * 2) = w;
      }
    asm volatile("s_waitcnt lgkmcnt(0)" ::: "memory");
    bf16_t* yw = (bf16_t*)(ws + OFF_YDA) + (rowbase + q0 + 32 * qs) * DM + hd * 128;
#pragma unroll
    for (int i = 0; i < 8; ++i) { const int row = i * 4 + (lane >> 4), ch = lane & 15;
      const u32x4 v = *(const LAS u32x4*)(stg + row * 272 + ch * 16);
      *(u32x4*)(yw + (size_t)row * DM + ch * 8) = v; }
  }
  __syncthreads();
}

constexpr int NS_STR = 144, NS_STAGE = 2 * 64 * NS_STR, NS_IMPW = 3 * NS_STAGE, NS_SCORE = NS_IMPW + 8 * 32 * 33 * 4, NS_MASK = NS_SCORE + 32 * 33 * 4, NS_UMASK = NS_MASK + 128, NS_LIST = NS_UMASK + 16;
struct CmpCap { float qs[2][8], ls[2][8], mrec[2]; };
template <int MODE, int SLOT> DI void ns_valu(volatile LAS int* jl, int t, int ntl, int qpos, int h, int blk, f32x16& s0, f32x16& s1, f32x16& du0, f32x16& du1, f32x16 (&O)[2], float& muse, float& l, bf16x8 (&P)[4], CmpCap& cap) {
    if (t < ntl) {
      const int j = __builtin_amdgcn_readfirstlane(jl[t]);
      if (MODE == 0) {
        const int lim = ((qpos - 31) >> 4) - 64 * j - 4 * h;
#pragma unroll
        for (int i = 0; i < 16; ++i) { const int ci = (i & 3) + 8 * (i >> 2); if (ci > lim) s0[i] = NEG; if (ci + 32 > lim) s1[i] = NEG; }
      } else if (MODE == 1) {
        if (j == blk) {
          const int lim = qpos - 64 * j - 4 * h;
#pragma unroll
          for (int i = 0; i < 16; ++i) { const int ci = (i & 3) + 8 * (i >> 2); if (ci > lim) s0[i] = NEG; if (ci + 32 > lim) s1[i] = NEG; }
        }
      } else {
        if (j == blk || j + 8 == blk) {
          const int lim = qpos - 64 * j - 4 * h, lo = lim - 512;
#pragma unroll
          for (int i = 0; i < 16; ++i) { const int ci = (i & 3) + 8 * (i >> 2); if (ci > lim || ci <= lo) s0[i] = NEG; if (ci + 32 > lim || ci + 32 <= lo) s1[i] = NEG; }
        }
      }
      softmax_def<2, false>(s0, s1, du0, du1, O, muse, l, t == 0, P);
      if (MODE == 0) {
#pragma unroll
        for (int ii = 0; ii < 4; ++ii) { cap.qs[SLOT][ii] = (s0[4 * ii] + s0[4 * ii + 1]) + (s0[4 * ii + 2] + s0[4 * ii + 3]); cap.ls[SLOT][ii] = s0[4 * ii + 3];
          cap.qs[SLOT][4 + ii] = (s1[4 * ii] + s1[4 * ii + 1]) + (s1[4 * ii + 2] + s1[4 * ii + 3]); cap.ls[SLOT][4 + ii] = s1[4 * ii + 3]; }
        cap.mrec[SLOT] = muse;
      }
    }
}
template <int MODE>
DI void nsa_branch(lds8* lds, const bf16_t* kg, const bf16_t* vg, int pitch, unsigned tiles, const bf16x8 (&q)[4], int qpos, unsigned mybits, int blk,
                   f32x16 (&O)[2], float& muse, float& l, int tid, int lane, int grp, CmpCap& cap) {
  const int r = lane & 31, h = lane >> 5;
  const int sr = tid >> 3, sc = tid & 7;
  const int koff = r * NS_STR + h * 16;
  const int voff = 64 * NS_STR + (4 * h + ((lane & 15) >> 2)) * NS_STR + ((lane >> 4) & 1) * 32 + (lane & 3) * 8;
  volatile LAS int* jl = (volatile LAS int*)(lds + NS_LIST);
  tiles = __builtin_amdgcn_readfirstlane(tiles);
  const int ntl = __builtin_popcount(tiles);
  if (tid < 32) { unsigned below = tiles & ((1u << tid) - 1u); if ((tiles >> tid) & 1u) jl[__builtin_popcount(below)] = tid; }
  __syncthreads();
#pragma unroll
  for (int d = 0; d < 2; ++d)
#pragma unroll
    for (int i = 0; i < 16; ++i) O[d][i] = 0.f;
  muse = 0.f; l = 0.f;
  u32x4 kra, vra;
#define NS_GLOAD(k_, KR, VR) do { const int jj = __builtin_amdgcn_readfirstlane(jl[(k_)]); KR = *(const u32x4*)(kg + (size_t)(64 * jj + sr) * pitch + sc * 8); VR = *(const u32x4*)(vg + (size_t)(64 * jj + sr) * pitch + sc * 8); } while (0)
#define NS_LSTORE(st_, KR, VR) do { lds8* b = lds + (st_) * NS_STAGE; *(LAS u32x4*)(b + sr * NS_STR + sc * 16) = KR; *(LAS u32x4*)(b + 64 * NS_STR + sr * NS_STR + sc * 16) = VR; } while (0)
  NS_GLOAD(0, kra, vra); NS_LSTORE(0, kra, vra);
  if (ntl > 1) { NS_GLOAD(1, kra, vra); NS_LSTORE(1, kra, vra); }
  __syncthreads();
  f32x16 s0, s1, du0, du1; bf16x8 P[4];
  int st_cur = 0;
#define NS_STEP(KR, VR, SLOT_) do { \
    if (t + 2 < ntl) NS_GLOAD(t + 2, KR, VR); \
    SBAR(); \
    { float bias = -muse; \
      if (MODE == 1) { const int jq = __builtin_amdgcn_readfirstlane(jl[t]); if (!((mybits >> jq) & 1u)) bias = NEG; } \
      qk64b<NS_STR>(s0, s1, lds + st_cur * NS_STAGE + koff, q, bias); } \
    ns_valu<MODE, SLOT_>(jl, t, ntl, qpos, h, blk, s0, s1, du0, du1, O, muse, l, P, cap); \
    pv64<NS_STR, 2>(O, lds + st_cur * NS_STAGE + voff, P); \
    if (t + 2 < ntl) NS_LSTORE((st_cur == 0) ? 2 : st_cur - 1, KR, VR); \
    st_cur = (st_cur == 2) ? 0 : st_cur + 1; \
    __syncthreads(); } while (0)
  for (int t = 0; t < ntl; ++t) {
    NS_STEP(kra, vra, 0);
    ++t; if (t >= ntl) break;
    NS_STEP(kra, vra, 1);
  }
#undef NS_STEP
#undef NS_GLOAD
#undef NS_LSTORE
}
DI void nsa_unit(const Params& p, lds8* lds, int bl, int g, int qb32) {
  int tid = threadIdx.x; asm volatile("" : "+v"(tid));
  const int lane = tid & 63, wid = __builtin_amdgcn_readfirstlane(tid >> 6);
  unsigned char* ws = p.ws;
  bf16_t* QNS = (bf16_t*)(ws + OFF_QNS); const bf16_t* KSW = (const bf16_t*)(ws + OFF_KSW); const bf16_t* VSW = (const bf16_t*)(ws + OFF_VSW);
  const bf16_t* KC = (const bf16_t*)(ws + OFF_KC); const bf16_t* VC = (const bf16_t*)(ws + OFF_VC); const bf16_t* GNS = (const bf16_t*)(ws + OFF_GNS);
  const float* rope = (const float*)(ws + OFF_ROPE);
  const int r = lane & 31, h = lane >> 5; const int hh = g * 8 + wid;
  const size_t rowbase = (size_t)bl * SEQ; const int q0 = qb32 * 32, qpos = q0 + r, blk = q0 >> 6;
  bf16x8 qraw[4], qrot[4];
  { const bf16_t* qp = QNS + (rowbase + qpos) * DM + hh * 64 + 8 * h;
#pragma unroll
    for (int ks = 0; ks < 4; ++ks) qraw[ks] = *(const bf16x8*)(qp + 16 * ks); }
  const bf16_t* gp = GNS + (rowbase + qpos) * 64 + hh * 3;
  const float g0 = bf2f(gp[0]), g1 = bf2f(gp[1]), g2 = bf2f(gp[2]);
  f32x16 OT[2], O[2]; float m, l; const int grp = ((wid >> 2) ^ wid) & 1;
  const bf16_t* kc = KC + (size_t)(bl * 2 + g) * 128 * 64; const bf16_t* vc = VC + (size_t)(bl * 2 + g) * 128 * 64;
  CmpCap cap;
  nsa_branch<0>(lds, kc, vc, 64, 3u, qraw, qpos, 0u, blk, O, m, l, tid, lane, grp, cap);
  const float lt0 = l + __shfl_xor(l, 32); const float inv0 = lt0 > 0.f ? 1.f / lt0 : 0.f;
  { const float f = g0 * inv0;
#pragma unroll
    for (int d = 0; d < 2; ++d)
#pragma unroll
      for (int i = 0; i < 16; ++i) OT[d][i] = O[d][i] * f; }
  { LAS float* impw = (LAS float*)(lds + NS_IMPW) + (wid * 32 + r) * 33;
    float carry = 0.f;
#pragma unroll
    for (int kt = 0; kt < 2; ++kt) {
      const float scale = __builtin_amdgcn_exp2f(cap.mrec[kt] - m) * inv0;
#pragma unroll
      for (int kb = 0; kb < 2; ++kb)
#pragma unroll
        for (int ii = 0; ii < 4; ++ii) {
          const float qsum = cap.qs[kt][kb * 4 + ii] * scale, last = cap.ls[kt][kb * 4 + ii] * scale;
          const float other = __shfl_xor(last, 32);
          const int ub = 16 * kt + 8 * kb + 2 * ii;
          const float val = qsum + (h ? other : carry);
          carry = other;
          impw[ub + h] = val;
        }
    }
  }
  __syncthreads();
#pragma unroll
  for (int ks = 0; ks < 2; ++ks) {
    const float* rc = rope + qpos * 32 + 16 * ks + 8 * h;
    const f32x4 c0 = *(const f32x4*)rc, c1 = *(const f32x4*)(rc + 4), s0 = *(const f32x4*)(rc + 65536), s1 = *(const f32x4*)(rc + 65536 + 4);
    float o1[8], o2[8];
#pragma unroll
    for (int e = 0; e < 8; ++e) { const float x1 = bf2f((unsigned short)qraw[ks][e]), x2 = bf2f((unsigned short)qraw[ks + 2][e]); const float cc = e < 4 ? c0[e & 3] : c1[e & 3], sn = e < 4 ? s0[e & 3] : s1[e & 3];
      o1[e] = x1 * cc - x2 * sn; o2[e] = x2 * cc + x1 * sn; }
    u32x4 w; w.x = cvtpk(o1[0], o1[1]); w.y = cvtpk(o1[2], o1[3]); w.z = cvtpk(o1[4], o1[5]); w.w = cvtpk(o1[6], o1[7]); qrot[ks] = __builtin_bit_cast(bf16x8, w);
    w.x = cvtpk(o2[0], o2[1]); w.y = cvtpk(o2[2], o2[3]); w.z = cvtpk(o2[4], o2[5]); w.w = cvtpk(o2[6], o2[7]); qrot[ks + 2] = __builtin_bit_cast(bf16x8, w);
  }
  LAS float* score = (LAS float*)(lds + NS_SCORE); LAS unsigned* maskl = (LAS unsigned*)(lds + NS_MASK); LAS unsigned* umaskl = (LAS unsigned*)(lds + NS_UMASK);
  if (tid == 0) *umaskl = 0u;
  { const LAS float* iw = (const LAS float*)(lds + NS_IMPW);
    for (int idx = tid; idx < 32 * 32; idx += 512) { const int qq = idx >> 5, s = idx & 31; float a = 0.f;
#pragma unroll
      for (int w = 0; w < 8; ++w) a += iw[(w * 32 + qq) * 33 + s];
      if (s == 0 || s == blk || s == blk - 1) a = 1e9f;
      score[qq * 33 + s] = a; } }
  __syncthreads();
  { const int qq = tid >> 4, sb2 = (tid & 15) * 2; unsigned bits = 0u;
#pragma unroll
    for (int e = 0; e < 2; ++e) { const int s = sb2 + e;
      if (s <= blk) { const float v = score[qq * 33 + s]; int rank = 0;
        for (int s2 = 0; s2 <= blk; ++s2) { const float v2 = score[qq * 33 + s2]; rank += (v2 > v || (v2 == v && s2 < s)) ? 1 : 0; }
        if (rank < 16) bits |= 1u << s; } }
    bits |= __shfl_xor(bits, 1); bits |= __shfl_xor(bits, 2); bits |= __shfl_xor(bits, 4); bits |= __shfl_xor(bits, 8);
    if ((tid & 15) == 0) { maskl[qq] = bits; atomicOr((unsigned*)umaskl, bits); } }
  __syncthreads();
  const unsigned mybits = maskl[r]; const unsigned umask = *umaskl;
  nsa_branch<1>(lds, KSW + rowbase * 256 + g * 64, VSW + rowbase * 256 + g * 64, 256, umask, qrot, qpos, mybits, blk, O, m, l, tid, lane, grp, cap);
  { const float lt = l + __shfl_xor(l, 32); const float f = g1 / lt;
#pragma unroll
    for (int d = 0; d < 2; ++d)
#pragma unroll
      for (int i = 0; i < 16; ++i) OT[d][i] += O[d][i] * f; }
  { const int jlo = blk >= 8 ? blk - 8 : 0; const unsigned wt = (blk == 31 ? 0xffffffffu : ((1u << (blk + 1)) - 1u)) & ~((1u << jlo) - 1u);
    nsa_branch<2>(lds, KSW + rowbase * 256 + 128 + g * 64, VSW + rowbase * 256 + 128 + g * 64, 256, wt, qrot, qpos, 0u, blk, O, m, l, tid, lane, grp, cap); }
  { const float lt = l + __shfl_xor(l, 32); const float f = g2 / lt;
#pragma unroll
    for (int d = 0; d < 2; ++d)
#pragma unroll
      for (int i = 0; i < 16; ++i) OT[d][i] += O[d][i] * f; }
  lds8* stg = lds + wid * (32 * 144);
#pragma unroll
  for (int d = 0; d < 2; ++d)
#pragma unroll
    for (int ii = 0; ii < 4; ++ii) {
      const int dv = 32 * d + 8 * ii + 4 * h;
      u32x2 w; w.x = cvtpk(OT[d][4 * ii], OT[d][4 * ii + 1]); w.y = cvtpk(OT[d][4 * ii + 2], OT[d][4 * ii + 3]);
      *(LAS u32x2*)(stg + r * 144 + dv * 2) = w;
    }
  asm volatile("s_waitcnt lgkmcnt(0)" ::: "memory");
  bf16_t* yw = (bf16_t*)(ws + OFF_YNS) + (rowbase + q0) * DM + hh * 64;
#pragma unroll
  for (int i = 0; i < 4; ++i) { const int row = i * 8 + (lane >> 3), ch = lane & 7;
    const u32x4 v = *(const LAS u32x4*)(stg + row * 144 + ch * 16);
    *(u32x4*)(yw + (size_t)row * DM + ch * 8) = v; }
}

#ifndef PH_FFN
#define PH_FFN 1
#endif
#ifndef PH_WIN
#define PH_WIN 1
#endif
#ifndef PH_CMP
#define PH_CMP 1
#endif
#ifndef PH_DA
#define PH_DA 1
#endif
#ifndef PH_NSA
#define PH_NSA 1
#endif
#ifndef PH_MRG1
#define PH_MRG1 1
#endif
#ifndef PH_OUT
#define PH_OUT 1
#endif
#ifndef REP_PRO
#define REP_PRO 1
#endif
#ifndef REP_SYNC
#define REP_SYNC 0
#endif
#ifndef REP_CMP
#define REP_CMP 1
#endif
#ifndef REP_UP
#define REP_UP 1
#endif
#ifndef REP_DA
#define REP_DA 1
#endif
#ifndef REP_NSA
#define REP_NSA 1
#endif
#ifndef PH_MRG
#define PH_MRG 1
#endif

#define XB_TMO      128
#define XB_XCNT(j)  (256  + 64 * (j))
#define XB_XSUB(j)  (1280 + 64 * (j))
#define XB_XGEN(j)  (2304 + 64 * (j))
#define XB_TOP      3328
#define XB_TOPGEN   3392
#define XCD_BAR_WORDS 3456
#define XB_SPIN_CAP (1u << 18)

__device__ __forceinline__ unsigned xb_ld(unsigned* p)              { return __hip_atomic_load(p, __ATOMIC_RELAXED, __HIP_MEMORY_SCOPE_AGENT); }
__device__ __forceinline__ unsigned xb_add(unsigned* p, unsigned v) { return __hip_atomic_fetch_add(p, v, __ATOMIC_RELAXED, __HIP_MEMORY_SCOPE_AGENT); }
__device__ __forceinline__ unsigned xb_xcc_id() { return (unsigned)__builtin_amdgcn_s_getreg((3 << 11) | 20) & 0xFu; }
#define XB_SPIN(cond, bar) do { unsigned _sp = 0; while (cond) { __builtin_amdgcn_s_sleep(1); \
    if ((++_sp & 255u) == 0u) { if (xb_ld(&(bar)[XB_TMO])) break; if (_sp > XB_SPIN_CAP) { atomicAdd(&(bar)[XB_TMO], 1u); break; } } } } while (0)

struct XcdBarrier {
    unsigned* bar; unsigned x;
    volatile LAS unsigned* st;
};

__device__ __forceinline__ XcdBarrier xcd_barrier_post(unsigned* bar, volatile LAS unsigned* st) {
    XcdBarrier b; b.bar = bar; b.x = xb_xcc_id(); b.st = st;
    if (threadIdx.x == 0) (void)xb_add(&bar[XB_XCNT(b.x)], 1u);
    return b;
}
__device__ __forceinline__ void xcd_barrier_complete(unsigned* bar, unsigned x, unsigned& nloc, unsigned& nx) {
    const unsigned G = gridDim.x * gridDim.y * gridDim.z;
    unsigned sum, cnt, mine, sp = 0u;
    for (;;) {
        sum = 0u; cnt = 0u; mine = 0u;
#pragma unroll
        for (unsigned j = 0; j < 16; ++j) { const unsigned c = xb_ld(&bar[XB_XCNT(j)]); sum += c; cnt += (c > 0u) ? 1u : 0u; mine = (j == x) ? c : mine; }
        if (sum == G) break;
        __builtin_amdgcn_s_sleep(1);
        if ((++sp & 255u) == 0u) { if (xb_ld(&bar[XB_TMO])) break; if (sp > XB_SPIN_CAP) { atomicAdd(&bar[XB_TMO], 1u); break; } }
    }
    nloc = mine > 0u ? mine : 1u; nx = cnt > 0u ? cnt : 1u;
}

__device__ __forceinline__ void xcd_barrier(const XcdBarrier& b) {
    asm volatile("s_waitcnt vmcnt(0)" ::: "memory");
    __syncthreads();
    if (threadIdx.x == 0) {
        unsigned* bar = b.bar;
        __builtin_amdgcn_s_waitcnt(0);
        unsigned nloc = b.st[0], nx = b.st[1];
        if (nloc == 0u) { xcd_barrier_complete(bar, b.x, nloc, nx); b.st[0] = nloc; b.st[1] = nx; }
        const unsigned old = xb_add(&bar[XB_XSUB(b.x)], 1u);
        const unsigned gen = old / nloc;
        if (old + 1u == (gen + 1u) * nloc) {
            __builtin_amdgcn_fence(__ATOMIC_RELEASE, "agent");
            asm volatile("s_waitcnt vmcnt(0)" ::: "memory");
            const unsigned og = xb_add(&bar[XB_TOP], 1u);
            const unsigned tg = og / nx;
            if (og + 1u == (tg + 1u) * nx) xb_add(&bar[XB_TOPGEN], 1u);
            else XB_SPIN(xb_ld(&bar[XB_TOPGEN]) == tg, bar);
            __builtin_amdgcn_fence(__ATOMIC_ACQUIRE, "agent");
            xb_add(&bar[XB_XGEN(b.x)], 1u);
            asm volatile("s_waitcnt vmcnt(0)" ::: "memory");
        } else {
            XB_SPIN(xb_ld(&bar[XB_XGEN(b.x)]) == gen, bar);
            __builtin_amdgcn_fence(__ATOMIC_ACQUIRE, "agent");
            asm volatile("s_waitcnt vmcnt(0)" ::: "memory");
        }
    }
    __syncthreads();
}

DI void ablk_prep_block(const Params& p, int pm) {
  int tid = threadIdx.x; asm volatile("" : "+v"(tid));
  const bf16_t* KVC = (const bf16_t*)(p.ws + OFF_KVC); bf16_t* AB = (bf16_t*)(p.ws + OFF_ABLK);
  const int kv = pm >> 4, bl = pm & 15;
  for (int idx = tid; idx < 256 * 256; idx += 512) {
    const int ch = idx & 255, rl = idx >> 8;
    const int g = rl & 1, n = rl >> 1; const int l = ch >> 3, d0 = (ch & 7) * 8;
    u32x4 o = {0u, 0u, 0u, 0u};
    if (n < 127) {
      const u32x4 v = *(const u32x4*)(KVC + ((size_t)bl * SEQ + 16 * n + l) * 256 + kv * 128 + g * 64 + d0);
      const float* ps = p.cmp_pos + (kv * 32 + l) * 64 + d0; const f32x4 p0 = *(const f32x4*)ps, p1 = *(const f32x4*)(ps + 4);
      o.x = cvtpk(bflo(v.x) + p0[0], bfhi(v.x) + p0[1]); o.y = cvtpk(bflo(v.y) + p0[2], bfhi(v.y) + p0[3]);
      o.z = cvtpk(bflo(v.z) + p1[0], bfhi(v.z) + p1[1]); o.w = cvtpk(bflo(v.w) + p1[2], bfhi(v.w) + p1[3]);
    }
    *(u32x4*)(AB + ((size_t)pm * 256 + rl) * 2048 + ch * 8) = o;
  }
}
DI void cmp_gemm2_block(const Params& p, lds8* lds, int pm) {
  int tid = threadIdx.x; asm volatile("" : "+v"(tid));
  const int kv = pm >> 4, bl = pm & 15;
  LAS float* wl = (LAS float*)lds;
  const float* w2 = p.cmp_w2 + (size_t)kv * 256 * 64;
  for (int i = tid; i < 256 * 64 / 4; i += 512) *(LAS f32x4*)(wl + i * 4) = *(const f32x4*)(w2 + i * 4);
  __syncthreads();
  const int rl = tid >> 1, dh = (tid & 1) * 32;
  const bf16_t* hr = (const bf16_t*)(p.ws + OFF_HID) + ((size_t)pm * 256 + rl) * 256;
  float a[32];
#pragma unroll
  for (int e = 0; e < 32; ++e) a[e] = 0.f;
#pragma unroll 1
  for (int j = 0; j < 256; j += 2) {
    const unsigned hv = *(const unsigned*)(hr + j);
    const float h0 = bflo(hv), h1 = bfhi(hv);
    const LAS float* w0 = wl + j * 64 + dh;
#pragma unroll
    for (int e4 = 0; e4 < 8; ++e4) { const f32x4 wa = *(const LAS f32x4*)(w0 + 4 * e4), wb = *(const LAS f32x4*)(w0 + 64 + 4 * e4);
      a[4 * e4] += h0 * wa[0] + h1 * wb[0]; a[4 * e4 + 1] += h0 * wa[1] + h1 * wb[1]; a[4 * e4 + 2] += h0 * wa[2] + h1 * wb[2]; a[4 * e4 + 3] += h0 * wa[3] + h1 * wb[3]; }
  }
  const int g = rl & 1, n = rl >> 1;
  bf16_t* dst = (bf16_t*)(p.ws + (kv ? OFF_VC : OFF_KC)) + ((size_t)(bl * 2 + g) * 128 + n) * 64 + dh;
#pragma unroll
  for (int e8 = 0; e8 < 4; ++e8) { u32x4 w; w.x = cvtpk(a[8 * e8], a[8 * e8 + 1]); w.y = cvtpk(a[8 * e8 + 2], a[8 * e8 + 3]); w.z = cvtpk(a[8 * e8 + 4], a[8 * e8 + 5]); w.w = cvtpk(a[8 * e8 + 6], a[8 * e8 + 7]);
    *(u32x4*)(dst + 8 * e8) = w; }
  __syncthreads();
}
#define BLOCK_SEAM() do { asm volatile("s_waitcnt vmcnt(0)" ::: "memory"); __syncthreads(); __builtin_amdgcn_fence(__ATOMIC_ACQUIRE, "agent"); asm volatile("s_waitcnt vmcnt(0)" ::: "memory"); } while (0)

__global__ void __launch_bounds__(512, 2) fwd_mega(Params p) {
  extern __shared__ __attribute__((aligned(16))) unsigned char lds_raw[];
  lds8* lds = (lds8*)lds_raw;
  cg::grid_group grid = cg::this_grid();
  const int G = gridDim.x, bid = blockIdx.x;
  const int NGW = G * 8, nthr = G * 512;
  unsigned char* ws = p.ws;
  float* ssq = (float*)(ws + OFF_SSQ);
  bf16_t* XB = (bf16_t*)(ws + OFF_XB); bf16_t* H = (bf16_t*)(ws + OFF_BIG);
  using pg8::Gemm; using pg8::StaticOrder;
  volatile LAS unsigned* bst = (volatile LAS unsigned*)(lds + 131072 + 256);
  if (threadIdx.x < 2) bst[threadIdx.x] = 0u;
  __syncthreads();
  (void)xcd_barrier_post((unsigned*)(ws + OFF_BAR), bst);
#define GSYNC() do { XcdBarrier b_; b_.bar = (unsigned*)(p.ws + OFF_BAR); b_.x = xb_xcc_id(); b_.st = (volatile LAS unsigned*)(lds + 131072 + 256); xcd_barrier(b_); } while (0)

  for (int rep = 0; rep < REP_PRO; ++rep) prologue(p, lds, NGW);
  if (p.ws == nullptr) grid.sync();
  GSYNC();
  for (int rep = 0; rep < REP_SYNC; ++rep) GSYNC();
#if PH_FFN
  for (int rep = 0; rep < REP_UP; ++rep)
  { Gemm g{XB, (const bf16_t*)(ws + OFF_W13_1), MTOK, 2 * DFF, DM}; StaticOrder S; S.init(MTOK, 2 * DFF, G, bid); EpiSwiGLU E{H, ssq};
    pg8::gemm_phase<EpiSwiGLU, StaticOrder, true, true>(lds, g, S, E); }
  GSYNC();
  { Gemm g{H, (const bf16_t*)(ws + OFF_W2_1), MTOK, DM, DFF}; StaticOrder S; S.init(MTOK, DM, G, bid); EpiResid E{XB, XB, ssq + MTOK, 0.5f, 0};
    pg8::gemm_phase<EpiResid, StaticOrder, true, true>(lds, g, S, E); }
  GSYNC();
#endif
  float lam;
  { float a = 0.f, b = 0.f;
    for (int i = 0; i < 64; ++i) { a += p.da_lambda[i] * p.da_lambda[64 + i]; b += p.da_lambda[128 + i] * p.da_lambda[192 + i]; }
    lam = __uint_as_float(__builtin_amdgcn_readfirstlane(__float_as_uint(__expf(a) - __expf(b) + 0.2f))); }
  for (int ck = 0; ck < NCHUNK; ++ck) {
    const int row_off = ck * MC;
#if PH_WIN
    { Gemm g{XB + (size_t)row_off * DM, (const bf16_t*)(ws + OFF_WIN), MC, NIN, DM}; StaticOrder S; S.init(MC, NIN, G, bid);
      EpiWin E{ssq + MTOK, row_off, (const float*)(ws + OFF_ROPE), (bf16_t*)(ws + OFF_QDA), (bf16_t*)(ws + OFF_KDA), (bf16_t*)(ws + OFF_VDA), (bf16_t*)(ws + OFF_QNS),
               (bf16_t*)(ws + OFF_KVC), (bf16_t*)(ws + OFF_KSW), (bf16_t*)(ws + OFF_VSW), (bf16_t*)(ws + OFF_GNS), (bf16_t*)(ws + OFF_GA), (bf16_t*)(ws + OFF_GB)};
      pg8::gemm_phase<EpiWin, StaticOrder, true, true>(lds, g, S, E); }
#endif
    GSYNC();
    volatile LAS unsigned* wq = (volatile LAS unsigned*)(lds + 131072 + 512);
    unsigned* qcnt = (unsigned*)(ws + OFF_BAR + 14336) + ck * 128;
    unsigned* cflag = (unsigned*)(ws + OFF_BAR + 15360) + ck * 64;
#if PH_CMP
    if (bid < 32) {
      for (int rep = 0; rep < REP_CMP; ++rep) {
      ablk_prep_block(p, bid);
      BLOCK_SEAM();
      { Gemm g{(const bf16_t*)(ws + OFF_ABLK), (const bf16_t*)(ws + OFF_W1C), 8192, 512, 2048}; CmpOrder S{bid}; EpiGelu E{(bf16_t*)(ws + OFF_HID)};
        pg8::gemm_phase<EpiGelu, CmpOrder, true, true>(lds, g, S, E); }
      BLOCK_SEAM();
      cmp_gemm2_block(p, lds, bid);
      }
      asm volatile("s_waitcnt vmcnt(0)" ::: "memory");
      __syncthreads();
      if (threadIdx.x == 0) { __builtin_amdgcn_fence(__ATOMIC_RELEASE, "agent"); asm volatile("s_waitcnt vmcnt(0)" ::: "memory");
        __hip_atomic_fetch_add(cflag, 1u, __ATOMIC_RELAXED, __HIP_MEMORY_SCOPE_AGENT); }
    }
#endif
#if PH_DA
    for (int rep = 0; rep < REP_DA; ++rep) {
      if (threadIdx.x == 0) *wq = atomicAdd(qcnt + 64 * rep, 1u);
      __syncthreads();
      int u = (int)*wq;
      __syncthreads();
      while (u < 2048) {
        unsigned nxt = 0u;
        if (threadIdx.x == 0) nxt = atomicAdd(qcnt + 64 * rep, 1u);
        const int qb = 15 - (u >> 7), bh = u & 127; da_unit(p, lds, bh >> 3, bh & 7, qb, lam);
        if (threadIdx.x == 0) *wq = nxt;
        __syncthreads();
        u = (int)*wq;
        __syncthreads();
      }
    }
#endif
    if (threadIdx.x == 0) { while (__hip_atomic_load(cflag, __ATOMIC_RELAXED, __HIP_MEMORY_SCOPE_AGENT) < 32u) __builtin_amdgcn_s_sleep(4);
      __builtin_amdgcn_fence(__ATOMIC_ACQUIRE, "agent"); asm volatile("s_waitcnt vmcnt(0)" ::: "memory"); }
    __syncthreads();
#if PH_NSA
    for (int rep = 0; rep < REP_NSA; ++rep) {
      if (threadIdx.x == 0) *wq = atomicAdd(qcnt + 32 + 64 * rep, 1u);
      __syncthreads();
      int u = (int)*wq;
      __syncthreads();
      while (u < 2048) {
        unsigned nxt = 0u;
        if (threadIdx.x == 0) nxt = atomicAdd(qcnt + 32 + 64 * rep, 1u);
        const int qb32 = 63 - (u >> 5), bg = u & 31; nsa_unit(p, lds, bg >> 1, bg & 1, qb32);
        if (threadIdx.x == 0) *wq = nxt;
        __syncthreads();
        u = (int)*wq;
        __syncthreads();
      }
    }
#endif
    GSYNC();
#if PH_MRG
    { Gemm g{(const bf16_t*)(ws + OFF_YDA), (const bf16_t*)(ws + OFF_WPD), MC, DM, DM}; StaticOrder S; S.init(MC, DM, G, bid); EpiMerge<0> E{(const bf16_t*)(ws + OFF_GA), (bf16_t*)(ws + OFF_MRG)};
      pg8::gemm_phase<EpiMerge<0>, StaticOrder, true, true>(lds, g, S, E); }
#if PH_MRG1
    { Gemm g{(const bf16_t*)(ws + OFF_YNS), (const bf16_t*)(ws + OFF_WPN), MC, DM, DM}; StaticOrder S; S.init(MC, DM, G, bid); EpiMerge<1> E{(const bf16_t*)(ws + OFF_GB), (bf16_t*)(ws + OFF_MRG)};
      pg8::gemm_phase<EpiMerge<1>, StaticOrder, true, true>(lds, g, S, E); }
#endif
    GSYNC();
#if PH_OUT
    { Gemm g{(const bf16_t*)(ws + OFF_MRG), (const bf16_t*)(ws + OFF_WOUT), MC, DM, DM}; StaticOrder S; S.init(MC, DM, G, bid); EpiResid E{XB, XB, ssq + 2 * MTOK, 1.0f, row_off};
      pg8::gemm_phase<EpiResid, StaticOrder, true, true>(lds, g, S, E); }
#endif
#endif
    GSYNC();
  }
#if PH_FFN
  { Gemm g{XB, (const bf16_t*)(ws + OFF_W13_2), MTOK, 2 * DFF, DM}; StaticOrder S; S.init(MTOK, 2 * DFF, G, bid); EpiSwiGLU E{H, ssq + 2 * MTOK};
    pg8::gemm_phase<EpiSwiGLU, StaticOrder, true, true>(lds, g, S, E); }
  GSYNC();
  { Gemm g{H, (const bf16_t*)(ws + OFF_W2_2), MTOK, DM, DFF}; StaticOrder S; S.init(MTOK, DM, G, bid); EpiResid E{XB, XB, ssq + 3 * MTOK, 0.5f, 0};
    pg8::gemm_phase<EpiResid, StaticOrder, true, true>(lds, g, S, E); }
#endif
  GSYNC();
  { int tidf = threadIdx.x; asm volatile("" : "+v"(tidf)); const int lane = tidf & 63; const int gw = bid * 8 + (tidf >> 6);
    for (int m = gw; m < MTOK; m += 2 * NGW) {
      const int m2 = (m + NGW < MTOK) ? m + NGW : m;
      const float q1 = ssq[3 * MTOK + m], q2 = ssq[3 * MTOK + m2];
      const u32x4* xr = (const u32x4*)(XB + (size_t)m * DM) + lane; const u32x4* xr2 = (const u32x4*)(XB + (size_t)m2 * DM) + lane;
      const u32x4 va0 = xr[0], va1 = xr[64], vb0 = xr2[0], vb1 = xr2[64];
      const f32x4* gr = (const f32x4*)p.final_norm;
#pragma unroll
      for (int rr = 0; rr < 2; ++rr) {
        if (rr == 1 && m2 == m) break;
        const float rstd = rsqrtf((rr ? q2 : q1) * (1.f / DM) + EPSN);
        f32x4* orow = (f32x4*)(p.out + (size_t)(rr ? m2 : m) * DM);
#pragma unroll
        for (int j = 0; j < 2; ++j) { const u32x4 v = rr ? (j ? vb1 : vb0) : (j ? va1 : va0); const int c4 = (64 * j + lane) * 2;
          const f32x4 g0 = gr[c4], g1 = gr[c4 + 1];
          f32x4 o0, o1; o0[0] = bflo(v.x) * rstd * g0[0]; o0[1] = bfhi(v.x) * rstd * g0[1]; o0[2] = bflo(v.y) * rstd * g0[2]; o0[3] = bfhi(v.y) * rstd * g0[3];
          o1[0] = bflo(v.z) * rstd * g1[0]; o1[1] = bfhi(v.z) * rstd * g1[1]; o1[2] = bflo(v.w) * rstd * g1[2]; o1[3] = bfhi(v.w) * rstd * g1[3];
          __builtin_nontemporal_store(o0, &orow[c4]); __builtin_nontemporal_store(o1, &orow[c4 + 1]); }
      }
    } }
}

extern "C" void kernel_launch(void* const* d_in, const int* in_sizes, int n_in, void* d_out, int out_size, void* d_ws, size_t ws_size, hipStream_t stream) {
  constexpr int LDSB = 147456;
  static int grid_blocks = 0;
  if (!grid_blocks) {
    if (n_in != 20 || ws_size < WS_END || ws_size < OFF_BIG + (size_t)MTOK * DFF * 2) { fprintf(stderr, "kernel_launch: unexpected inputs / workspace (%d inputs, %zu bytes)\n", n_in, ws_size); grid_blocks = -1; return; }
    int dev = 0, cus = 0, per_cu = 0;
    (void)hipGetDevice(&dev);
    (void)hipDeviceGetAttribute(&cus, hipDeviceAttributeMultiprocessorCount, dev);
    (void)hipFuncSetAttribute((const void*)fwd_mega, hipFuncAttributeMaxDynamicSharedMemorySize, LDSB);
    (void)hipOccupancyMaxActiveBlocksPerMultiprocessor(&per_cu, (const void*)fwd_mega, 512, LDSB);
    if (per_cu < 1) per_cu = 1;
    grid_blocks = cus * per_cu;
  }
  if (grid_blocks < 0) return;
  Params p{};
  const float** pp = (const float**)&p;
  for (int i = 0; i < 20; ++i) pp[i] = (const float*)d_in[i];
  p.out = (float*)d_out; p.ws = (unsigned char*)d_ws;
  (void)hipMemsetAsync((unsigned char*)d_ws + OFF_BAR, 0, 16384, stream);
  void* args[] = {&p};
  hipError_t e = hipLaunchCooperativeKernel((void*)fwd_mega, dim3(grid_blocks), dim3(512), args, LDSB, stream);
  if (e != hipSuccess) fprintf(stderr, "cooperative launch failed: %s (grid %d)\n", hipGetErrorString(e), grid_blocks);
}
```
